# Optimizing an MI355X kernel written in HIP

```python
import jax, jax.numpy as jnp
from jax import lax
import numpy as np

D_MODEL = 1024
BATCH = 1
SEQ = 16384
DEPTH = 4

N_MEM = 256
N_EVEN = (DEPTH + 1) // 2
N_ODD = DEPTH // 2
MIX_WIDTH = D_MODEL
EPS = 1e-6

MLA_HEADS = 8
MLA_NOPE = 64
MLA_ROPE = 32
MLA_V = 64
MLA_Q_RANK = 256
MLA_KV_RANK = 128
ROPE_THETA = 10000.0
Q_BLOCK = 128

GLA_HEADS = 4
GLA_DK = 64
GLA_DV = 128
GLA_GATE_RANK = 16
GLA_TAU = 16.0
GLA_CHUNK = 64

MLSTM_HEADS = 4
MLSTM_DH = MIX_WIDTH // MLSTM_HEADS
MLSTM_CONV = 4
MLSTM_CHUNK = 64

XATTN_HEADS = 4
XATTN_DH = D_MODEL // XATTN_HEADS

D_FF = 4 * D_MODEL

EVEN_SPLITS = (MLA_Q_RANK, MLA_KV_RANK, MLA_ROPE, GLA_HEADS * GLA_DK, GLA_HEADS * GLA_DK,
               GLA_HEADS * GLA_DV, GLA_GATE_RANK, GLA_HEADS * GLA_DV)
EVEN_IN = sum(EVEN_SPLITS)
EVEN_OUT = MLA_HEADS * MLA_V + GLA_HEADS * GLA_DV

kernel_name = "hybrid_mla_gla_mlstm_sandwich_trunk"


def _rmsnorm(x, g):
    xf = x.astype(jnp.float32)
    y = xf * lax.rsqrt(jnp.mean(xf * xf, axis=-1, keepdims=True) + EPS)
    return (y * g.astype(jnp.float32)).astype(x.dtype)


def _layernorm(x, g):
    xf = x.astype(jnp.float32)
    mu = jnp.mean(xf, axis=-1, keepdims=True)
    xc = xf - mu
    y = xc * lax.rsqrt(jnp.mean(xc * xc, axis=-1, keepdims=True) + EPS)
    return (y * g.astype(jnp.float32)).astype(x.dtype)


def _rope_tables(positions, dim):
    inv_freq = ROPE_THETA ** (-jnp.arange(0, dim, 2, dtype=jnp.float32) / dim)
    ang = positions.astype(jnp.float32)[..., None] * inv_freq
    return jnp.cos(ang), jnp.sin(ang)


def _apply_rope(x, cos, sin):
    x1, x2 = jnp.split(x.astype(jnp.float32), 2, axis=-1)
    return jnp.concatenate([x1 * cos - x2 * sin, x2 * cos + x1 * sin], axis=-1).astype(x.dtype)


def _to_chunks(t, L):
    B, S, H, d = t.shape
    return t.reshape(B, S // L, L, H, d).transpose(1, 0, 3, 2, 4)


def _from_chunks(t):
    nc, B, H, L, d = t.shape
    return t.transpose(1, 0, 3, 2, 4).reshape(B, nc * L, H, d)


def _mla(c_q, c_kv, k_pe, positions, g_q, w_uq, g_kv, w_ukv):
    B, S, _ = c_q.shape
    H = MLA_HEADS
    q = (_rmsnorm(c_q, g_q) @ w_uq).reshape(B, S, H, MLA_NOPE + MLA_ROPE)
    q_nope, q_pe = q[..., :MLA_NOPE], q[..., MLA_NOPE:]
    kv = (_rmsnorm(c_kv, g_kv) @ w_ukv).reshape(B, S, H, MLA_NOPE + MLA_V)
    k_nope, v = kv[..., :MLA_NOPE], kv[..., MLA_NOPE:]
    cos, sin = _rope_tables(positions, MLA_ROPE)
    q_pe = _apply_rope(q_pe, cos[:, :, None, :], sin[:, :, None, :])
    k_pe = _apply_rope(k_pe, cos, sin)
    scale = (MLA_NOPE + MLA_ROPE) ** -0.5
    nb = S // Q_BLOCK
    key_idx = jnp.arange(S)

    def to_blocks(t):
        return jnp.moveaxis(t.reshape(B, nb, Q_BLOCK, *t.shape[2:]), 1, 0)

    def attend(blk):
        qn, qp, bi = blk
        s = (jnp.einsum('bqhd,bkhd->bhqk', qn, k_nope)
             + jnp.einsum('bqhr,bkr->bhqk', qp, k_pe)).astype(jnp.float32) * scale
        q_idx = bi * Q_BLOCK + jnp.arange(Q_BLOCK)
        s = jnp.where(key_idx[None, :] <= q_idx[:, None], s, -jnp.inf)
        p = jax.nn.softmax(s, axis=-1).astype(v.dtype)
        return jnp.einsum('bhqk,bkhd->bqhd', p, v)

    o = lax.map(attend, (to_blocks(q_nope), to_blocks(q_pe), jnp.arange(nb)))
    return jnp.moveaxis(o, 0, 1).reshape(B, S, H * MLA_V)


def _gla(q, k, v, g_lr, r, w_gate, b_gate, g_norm):
    B, S, _ = q.shape
    H, DK, DV, L = GLA_HEADS, GLA_DK, GLA_DV, GLA_CHUNK
    f32 = jnp.float32
    log_a = jax.nn.log_sigmoid((g_lr @ w_gate + b_gate).astype(f32)) / GLA_TAU
    qc = _to_chunks(q.astype(f32).reshape(B, S, H, DK) * DK ** -0.5, L)
    kc = _to_chunks(k.astype(f32).reshape(B, S, H, DK), L)
    vc = _to_chunks(v.astype(f32).reshape(B, S, H, DV), L)
    gc = _to_chunks(log_a.reshape(B, S, H, DK), L)
    causal = jnp.tril(jnp.ones((L, L), dtype=bool))

    def step(state, inp):
        qi, ki, vi, gi = inp
        b = jnp.cumsum(gi, axis=2)
        b_end = b[:, :, -1:, :]
        diff = b[:, :, :, None, :] - b[:, :, None, :, :]
        decay = jnp.exp(jnp.where(causal[:, :, None], diff, -jnp.inf))
        attn = jnp.einsum('bhtd,bhsd,bhtsd->bhts', qi, ki, decay)
        o = attn @ vi + (qi * jnp.exp(b)) @ state
        state = (jnp.exp(b_end).swapaxes(-1, -2) * state
                 + (ki * jnp.exp(b_end - b)).swapaxes(-1, -2) @ vi)
        return state, o

    _, o = lax.scan(step, jnp.zeros((B, H, DK, DV), f32), (qc, kc, vc, gc))
    o = _rmsnorm(_from_chunks(o), g_norm).reshape(B, S, H * DV)
    return (o * jax.nn.silu(r.astype(f32))).astype(q.dtype)


def _mlstm_cell(q, k, v, i_pre, f_pre):
    B, S, H, DH = q.shape
    L = MLSTM_CHUNK
    f32 = jnp.float32
    qc = _to_chunks(q.astype(f32) * DH ** -0.5, L)
    kc = _to_chunks(k.astype(f32), L)
    vc = _to_chunks(v.astype(f32), L)
    ic = _to_chunks(i_pre.astype(f32)[..., None], L)[..., 0]
    fc = _to_chunks(jax.nn.log_sigmoid(f_pre.astype(f32))[..., None], L)[..., 0]
    causal = jnp.tril(jnp.ones((L, L), dtype=bool))

    def step(carry, inp):
        C, n, m = carry
        qi, ki, vi, ii, lfi = inp
        b = jnp.cumsum(lfi, axis=-1)
        log_d = jnp.where(causal, b[..., :, None] - b[..., None, :] + ii[..., None, :], -jnp.inf)
        m_inter = b + m[..., None]
        m_t = jnp.maximum(m_inter, jnp.max(log_d, axis=-1))
        w_intra = jnp.exp(log_d - m_t[..., None]) * jnp.einsum('bhtd,bhsd->bhts', qi, ki)
        w_inter = jnp.exp(m_inter - m_t)
        num = w_intra @ vi + w_inter[..., None] * (qi @ C)
        den = jnp.sum(w_intra, axis=-1) + w_inter * jnp.einsum('bhtd,bhd->bht', qi, n)
        h = num / jnp.maximum(jnp.abs(den), jnp.exp(-m_t))[..., None]
        b_end = b[..., -1]
        log_w = b_end[..., None] - b + ii
        m_new = jnp.maximum(b_end + m, jnp.max(log_w, axis=-1))
        w_s = jnp.exp(log_w - m_new[..., None])
        carry_decay = jnp.exp(b_end + m - m_new)
        C = carry_decay[..., None, None] * C + jnp.einsum('bhs,bhsd,bhse->bhde', w_s, ki, vi)
        n = carry_decay[..., None] * n + jnp.einsum('bhs,bhsd->bhd', w_s, ki)
        return (C, n, m_new), h

    init = (jnp.zeros((B, H, DH, DH), f32), jnp.zeros((B, H, DH), f32), jnp.zeros((B, H), f32))
    _, h = lax.scan(step, init, (qc, kc, vc, ic, fc))
    return _from_chunks(h).astype(q.dtype)


def _causal_conv(x, w, b):
    C = x.shape[-1]
    y = lax.conv_general_dilated(x, w[:, None, :].astype(x.dtype), window_strides=(1,),
                                 padding=[(MLSTM_CONV - 1, 0)],
                                 dimension_numbers=('NWC', 'WIO', 'NWC'),
                                 feature_group_count=C)
    return y + b


def _even_mixer(hn, positions, w_in, g_q, w_uq, g_kv, w_ukv, w_gate, b_gate, g_gla, w_out):
    proj = hn @ w_in
    offs = np.cumsum(EVEN_SPLITS)[:-1].tolist()
    c_q, c_kv, k_pe, gq, gk, gv, g_lr, r = jnp.split(proj, offs, axis=-1)
    a = _mla(c_q, c_kv, k_pe, positions, g_q, w_uq, g_kv, w_ukv)
    g = _gla(gq, gk, gv, g_lr, r, w_gate, b_gate, g_gla)
    return jnp.concatenate([a, g], axis=-1) @ w_out


def _odd_mixer(hn, w_in, conv_w, conv_b, w_q, w_k, w_v, w_gates, b_gates, g_hnorm, skip, w_out):
    B, S, _ = hn.shape
    H, DH = MLSTM_HEADS, MLSTM_DH
    x_m, z = jnp.split(hn @ w_in, 2, axis=-1)
    x_c = jax.nn.silu(_causal_conv(x_m, conv_w, conv_b))
    xch = x_c.reshape(B, S, H, DH)
    xmh = x_m.reshape(B, S, H, DH)
    q = jnp.einsum('bshd,hde->bshe', xch, w_q)
    k = jnp.einsum('bshd,hde->bshe', xch, w_k)
    v = jnp.einsum('bshd,hde->bshe', xmh, w_v)
    gates = jnp.concatenate([q, k, v], axis=-1).reshape(B, S, 3 * MIX_WIDTH) @ w_gates + b_gates
    i_pre, f_pre = gates[..., :H], gates[..., H:]
    h = _mlstm_cell(q, k, v, i_pre, f_pre)
    h = _layernorm(h, g_hnorm.reshape(H, DH)).reshape(B, S, MIX_WIDTH)
    out = (h + skip * x_c) * jax.nn.silu(z)
    return out @ w_out


def _mem_xattn(hn, mem_n, w_q, w_k, w_v, w_o):
    B, S, _ = hn.shape
    M = mem_n.shape[1]
    q = (hn @ w_q).reshape(B, S, XATTN_HEADS, XATTN_DH)
    k = (mem_n @ w_k).reshape(B, M, XATTN_HEADS, XATTN_DH)
    v = (mem_n @ w_v).reshape(B, M, XATTN_HEADS, XATTN_DH)
    s = jnp.einsum('bshd,bmhd->bhsm', q, k).astype(jnp.float32) * XATTN_DH ** -0.5
    p = jax.nn.softmax(s, axis=-1).astype(v.dtype)
    return jnp.einsum('bhsm,bmhd->bshd', p, v).reshape(B, S, D_MODEL) @ w_o


def _sq_relu_mlp(hn, w1, w2):
    return jnp.square(jax.nn.relu(hn @ w1)) @ w2


def setup_inputs(seed: int = 0) -> dict:
    key = jax.random.key(seed)
    keys = jax.random.split(key, 64)
    ctr = [0]

    def nk():
        ctr[0] += 1
        return keys[ctr[0] - 1]

    def w(shape, fan_in):
        return jax.random.normal(nk(), shape, jnp.float32) * fan_in ** -0.5

    def gain(shape):
        return 1.0 + 0.05 * jax.random.normal(nk(), shape, jnp.float32)

    def small(shape, s=0.02):
        return s * jax.random.normal(nk(), shape, jnp.float32)

    x = jax.random.normal(nk(), (BATCH, SEQ, D_MODEL), jnp.float32)
    mem = jax.random.normal(nk(), (BATCH, N_MEM, D_MODEL), jnp.float32)
    offset = jax.random.randint(nk(), (BATCH, 1), 0, 4096, dtype=jnp.int32)
    positions = (offset + jnp.arange(SEQ, dtype=jnp.int32)[None, :]).astype(jnp.int32)

    f_bias = jnp.broadcast_to(jnp.linspace(3.0, 6.0, MLSTM_HEADS, dtype=jnp.float32), (N_ODD, MLSTM_HEADS))
    od_b_gates = jnp.concatenate([small((N_ODD, MLSTM_HEADS), 0.1),
                                  f_bias + small((N_ODD, MLSTM_HEADS), 0.1)], axis=-1)
    return {
        "x": x, "mem": mem, "positions": positions,
        "g_mix_pre": gain((DEPTH, D_MODEL)), "g_mix_post": gain((DEPTH, D_MODEL)),
        "g_xattn_pre": gain((DEPTH, D_MODEL)), "g_xattn_post": gain((DEPTH, D_MODEL)),
        "g_mem": gain((DEPTH, D_MODEL)),
        "g_ffn_pre": gain((DEPTH, D_MODEL)), "g_ffn_post": gain((DEPTH, D_MODEL)),
        "ev_w_in": w((N_EVEN, D_MODEL, EVEN_IN), D_MODEL),
        "ev_g_q": gain((N_EVEN, MLA_Q_RANK)),
        "ev_w_uq": w((N_EVEN, MLA_Q_RANK, MLA_HEADS * (MLA_NOPE + MLA_ROPE)), MLA_Q_RANK),
        "ev_g_kv": gain((N_EVEN, MLA_KV_RANK)),
        "ev_w_ukv": w((N_EVEN, MLA_KV_RANK, MLA_HEADS * (MLA_NOPE + MLA_V)), MLA_KV_RANK),
        "ev_w_gate": w((N_EVEN, GLA_GATE_RANK, GLA_HEADS * GLA_DK), GLA_GATE_RANK),
        "ev_b_gate": small((N_EVEN, GLA_HEADS * GLA_DK), 0.1),
        "ev_g_gla": gain((N_EVEN, GLA_DV)),
        "ev_w_out": w((N_EVEN, EVEN_OUT, D_MODEL), EVEN_OUT),
        "od_w_in": w((N_ODD, D_MODEL, 2 * MIX_WIDTH), D_MODEL),
        "od_conv_w": w((N_ODD, MLSTM_CONV, MIX_WIDTH), MLSTM_CONV),
        "od_conv_b": small((N_ODD, MIX_WIDTH)),
        "od_w_q": w((N_ODD, MLSTM_HEADS, MLSTM_DH, MLSTM_DH), MLSTM_DH),
        "od_w_k": w((N_ODD, MLSTM_HEADS, MLSTM_DH, MLSTM_DH), MLSTM_DH),
        "od_w_v": w((N_ODD, MLSTM_HEADS, MLSTM_DH, MLSTM_DH), MLSTM_DH),
        "od_w_gates": w((N_ODD, 3 * MIX_WIDTH, 2 * MLSTM_HEADS), 3 * MIX_WIDTH),
        "od_b_gates": od_b_gates,
        "od_g_hnorm": gain((N_ODD, MIX_WIDTH)),
        "od_skip": gain((N_ODD, MIX_WIDTH)),
        "od_w_out": w((N_ODD, MIX_WIDTH, D_MODEL), MIX_WIDTH),
        "xa_w_q": w((DEPTH, D_MODEL, D_MODEL), D_MODEL),
        "xa_w_k": w((DEPTH, D_MODEL, D_MODEL), D_MODEL),
        "xa_w_v": w((DEPTH, D_MODEL, D_MODEL), D_MODEL),
        "xa_w_o": w((DEPTH, D_MODEL, D_MODEL), D_MODEL),
        "ffn_w1": w((DEPTH, D_MODEL, D_FF), D_MODEL),
        "ffn_w2": w((DEPTH, D_FF, D_MODEL), D_FF),
    }


def reference(x, mem, positions,
              g_mix_pre, g_mix_post, g_xattn_pre, g_xattn_post, g_mem, g_ffn_pre, g_ffn_post,
              ev_w_in, ev_g_q, ev_w_uq, ev_g_kv, ev_w_ukv, ev_w_gate, ev_b_gate, ev_g_gla, ev_w_out,
              od_w_in, od_conv_w, od_conv_b, od_w_q, od_w_k, od_w_v, od_w_gates, od_b_gates,
              od_g_hnorm, od_skip, od_w_out,
              xa_w_q, xa_w_k, xa_w_v, xa_w_o,
              ffn_w1, ffn_w2):
    h = x
    for layer in range(DEPTH):
        j = layer // 2
        hn = _rmsnorm(h, g_mix_pre[layer])
        if layer % 2 == 0:
            mix = _even_mixer(hn, positions, ev_w_in[j], ev_g_q[j], ev_w_uq[j], ev_g_kv[j],
                              ev_w_ukv[j], ev_w_gate[j], ev_b_gate[j], ev_g_gla[j], ev_w_out[j])
        else:
            mix = _odd_mixer(hn, od_w_in[j], od_conv_w[j], od_conv_b[j], od_w_q[j], od_w_k[j],
                             od_w_v[j], od_w_gates[j], od_b_gates[j], od_g_hnorm[j], od_skip[j],
                             od_w_out[j])
        h = h + _rmsnorm(mix, g_mix_post[layer])
        mem_n = _rmsnorm(mem, g_mem[layer])
        xa = _mem_xattn(_rmsnorm(h, g_xattn_pre[layer]), mem_n,
                        xa_w_q[layer], xa_w_k[layer], xa_w_v[layer], xa_w_o[layer])
        h = h + _rmsnorm(xa, g_xattn_post[layer])
        f = _sq_relu_mlp(_rmsnorm(h, g_ffn_pre[layer]), ffn_w1[layer], ffn_w2[layer])
        h = h + _rmsnorm(f, g_ffn_post[layer])
    return h
```

```cpp
#include <hip/hip_runtime.h>
#include <cstdio>
#include <cstdint>

#define LAS __attribute__((address_space(3)))
#define GAS __attribute__((address_space(1)))
#define DEV __device__ __forceinline__
typedef unsigned short bf16_t;
typedef short bf16x8 __attribute__((ext_vector_type(8)));
typedef short s16x4 __attribute__((ext_vector_type(4)));
typedef float f32x4 __attribute__((ext_vector_type(4)));
typedef float f32x16 __attribute__((ext_vector_type(16)));
typedef float f32x2 __attribute__((ext_vector_type(2)));
typedef unsigned u32x4 __attribute__((ext_vector_type(4)));
typedef unsigned u32x2 __attribute__((ext_vector_type(2)));
typedef __bf16 bf16x2_t __attribute__((ext_vector_type(2)));
typedef short v4i16_t __attribute__((ext_vector_type(4)));

constexpr int S = 16384, D = 1024, NLAYER = 4, NMEM = 256, DFF = 4096;
constexpr float EPS = 1e-6f;
constexpr float LOG2E = 1.4426950408889634f;
constexpr int NTHREADS = 512, NWAVES = 8;

constexpr size_t MiB = 1u << 20, KiB = 1024;
constexpr size_t WS_CTL = 0;
constexpr size_t WS_COS = 1 * MiB;
constexpr size_t WS_SIN = 2 * MiB;
constexpr size_t WS_RSX = 3 * MiB;
constexpr size_t WS_SSQ16 = 4 * MiB;
constexpr size_t WS_SSQQ = 5 * MiB;
constexpr size_t WS_SSQKV = 5 * MiB + 256 * KiB;
constexpr size_t WS_GATES = 5 * MiB + 512 * KiB;
constexpr size_t WS_G12 = 6 * MiB;
constexpr size_t WS_GDEC = 6 * MiB + 128 * KiB;
constexpr size_t WS_MST = 6 * MiB + 512 * KiB;
constexpr size_t WS_KX = 8 * MiB;
constexpr size_t WS_VX = 10 * MiB;
constexpr size_t WS_MEMN = 12 * MiB;
constexpr size_t WS_WB = 16 * MiB;
constexpr size_t WS_HB = 44 * MiB;
constexpr size_t WS_MIX = 76 * MiB;
constexpr size_t WS_R = 108 * MiB;
constexpr size_t WS_END = 300 * MiB;
constexpr size_t WB_WIN = 0;
constexpr size_t WB_WUQ = 4 * MiB;
constexpr size_t WB_WUKV = 4 * MiB + 512 * KiB;
constexpr size_t WB_W3 = 4 * MiB;
constexpr size_t WB_WOUT = 6 * MiB;
constexpr size_t WB_XQ = 8 * MiB;
constexpr size_t WB_XO = 10 * MiB;
constexpr size_t WB_W1 = 12 * MiB;
constexpr size_t WB_W2 = 20 * MiB;
constexpr size_t R_PROJ = 0;
constexpr size_t R_Q = 64 * MiB;
constexpr size_t R_KN = 88 * MiB;
constexpr size_t R_V = 104 * MiB;
constexpr size_t R_CAT = 120 * MiB;
constexpr size_t R_GST = 152 * MiB;
constexpr size_t R_XQ = 0, R_XO = 32 * MiB;
constexpr size_t R_U = 0;
constexpr size_t R_XM = 0, R_Z = 32 * MiB, R_XC = 64 * MiB, R_MQ = 96 * MiB, R_MK = 128 * MiB, R_MV = 160 * MiB;
constexpr size_t R_XKT = 0;

constexpr int PJ_CQ = 0, PJ_CKV = 256, PJ_KPE = 384, PJ_GLR = 416, PJ_GQ = 512, PJ_GK = 768, PJ_GV = 1024, PJ_R = 1536;

constexpr int LDS_BYTES = 160 * 1024;
constexpr int LDS_MISC = 156 * 1024;

DEV unsigned pk2(float lo, float hi) { f32x2 v = {lo, hi}; bf16x2_t b = __builtin_convertvector(v, bf16x2_t); return __builtin_bit_cast(unsigned, b); }
DEV float bflo(unsigned u) { return __uint_as_float(u << 16); }
DEV float bfhi(unsigned u) { return __uint_as_float(u & 0xffff0000u); }
DEV float bf1(bf16_t b) { return __uint_as_float(((unsigned)b) << 16); }
DEV bf16_t f2bf(float f) { return (bf16_t)(pk2(f, 0.f) & 0xffffu); }
DEV float wave_sum(float v) {
#pragma unroll
    for (int o = 1; o < 64; o <<= 1) v += __shfl_xor(v, o);
    return v;
}
DEV int crow(int r, int hi) { return (r & 3) + 8 * (r >> 2) + 4 * hi; }
DEV float swap32_max(float m) { auto rr = __builtin_amdgcn_permlane32_swap(__float_as_uint(m), __float_as_uint(m), false, false); return fmaxf(__uint_as_float(rr[0]), __uint_as_float(rr[1])); }
DEV float swap32_sum(float m) { auto rr = __builtin_amdgcn_permlane32_swap(__float_as_uint(m), __float_as_uint(m), false, false); return __uint_as_float(rr[0]) + __uint_as_float(rr[1]); }
DEV int rope_perm(int l) { return 8 * ((l >> 2) & 3) + 4 * (l >> 4) + (l & 3); }
DEV float silu_f(float x) { return x / (1.f + __expf(-x)); }
DEV float logsigmoid_f(float x) { return fminf(x, 0.f) - __logf(1.f + __expf(-fabsf(x))); }
DEV float logsigmoid_ref(float x) { return fminf(x, 0.f) - log1pf(expf(-fabsf(x))); }
#define LDS_WAIT() asm volatile("s_waitcnt lgkmcnt(0)" ::: "memory")

struct Args {
    const float* in[36];
    float* out;
    unsigned char* ws;
    int ph_lo, ph_hi;
};

struct Ctx {
    LAS unsigned char* lds;
    int tid, lane, wave, G, vcu, gw, NGW;
};

struct CmId { int off; DEV int operator()(int n) const { return n + off; } };
struct CmE1 { DEV int operator()(int n) const {
    if (n < 384) return n;
    if (n < 416) return PJ_KPE + rope_perm(n - 384);
    if (n < 672) return PJ_GQ + (n - 416);
    if (n < 928) return PJ_GK + (n - 672);
    if (n < 1440) return PJ_GV + (n - 928);
    if (n < 1456) return PJ_GLR + (n - 1440);
    return PJ_R + (n - 1456); } };
struct CmQ { DEV int operator()(int n) const { const int h = n / 96, r = n - h * 96; return r < 64 ? n : h * 96 + 64 + rope_perm(r - 64); } };
struct CmKV { DEV int operator()(int n) const { const int h = n >> 7, r = n & 127; return r < 64 ? h * 64 + r : 512 + h * 64 + (r - 64); } };

template <class CM>
DEV void prep_job(const Ctx& c, const float* W, int ldw, int Ksrc, int Nsrc, const float* gk, float scale, bf16_t* WT, int ldt, const CM cm) {
    LAS float* scr = (LAS float*)(c.lds + c.wave * 8704);
    const int nblk = (Nsrc + 31) / 32, nitems = (Ksrc / 64) * nblk, lane = c.lane;
    for (int it = c.gw; it < nitems; it += c.NGW) {
        const int kb = it / nblk, nb = it - kb * nblk, k0 = kb * 64, n0 = nb * 32;
        const int nr = n0 + (lane & 31);
#pragma unroll 8
        for (int i = 0; i < 32; ++i) {
            const int kk = 2 * i + (lane >> 5);
            float v = (nr < Nsrc) ? W[(size_t)(k0 + kk) * ldw + nr] : 0.f;
            if (gk) v *= gk[k0 + kk];
            scr[kk * 33 + (lane & 31)] = v * scale;
        }
        LDS_WAIT(); asm volatile("" ::: "memory");
        const int cc = lane & 7;
#pragma unroll
        for (int j = 0; j < 4; ++j) {
            const int nl = (lane >> 3) + 8 * j, n = n0 + nl;
            if (n < Nsrc) {
                const int dr = cm(n);
                const LAS float* s = scr + (8 * cc) * 33 + nl;
                u32x4 o; o.x = pk2(s[0], s[33]); o.y = pk2(s[66], s[99]); o.z = pk2(s[132], s[165]); o.w = pk2(s[198], s[231]);
                *(u32x4*)(WT + (size_t)dr * ldt + k0 + 8 * cc) = o;
            }
        }
        LDS_WAIT(); asm volatile("" ::: "memory");
    }
}
DEV void zero_block(const Ctx& c, bf16_t* p, int rows, int cols, int ld) {
    const int cpr = cols / 8, n = rows * cpr;
    unsigned z = 0u; asm volatile("" : "+v"(z));
    for (int i = c.gw * 64 + c.lane; i < n; i += c.NGW * 64) { const int r = i / cpr, cc = i - r * cpr; *(u32x4*)(p + (size_t)r * ld + cc * 8) = (u32x4){z, z, z, z}; }
}

namespace pg8 {
constexpr int BM = 256, BK = 64, HALF = 128, HTB = HALF * BK * 2, STAGE_BYTES = 8 * HTB, NXCD = 8, WGM = 8;
__host__ __device__ __forceinline__ int lds_byte(int r, int c) { const int st = (r >> 4) * 2 + (c >> 5), rr = r & 15, cc = c & 31, ob = rr * 64 + cc * 2; return st * 1024 + (ob ^ (((ob >> 9) & 1) << 5)); }
__host__ __device__ __forceinline__ void stage_rc(int b, int& R, int& C) { const int st = b / 1024, sb = b % 1024, swz = sb ^ (((sb >> 9) & 1) << 5); R = (st >> 1) * 16 + swz / 64; C = (st & 1) * 32 + (swz % 64) / 2; }
__host__ __device__ __forceinline__ int perm32(int rho) { const int n = rho >> 4, i = rho & 15; return 8 * (i >> 2) + 4 * n + (i & 3); }
struct Unit { int pm, pn; };
struct StaticOrder {
    int nM, nN, nwg, G, c;
    DEV void init(int nM_, int nN_, int G_, int c_) { nM = nM_; nN = nN_; nwg = nM * nN; G = G_; c = c_; }
    DEV bool next(int i, Unit& u) const {
        const long L = (long)i * G + c; if (L >= nwg) return false;
        int wgid = (int)L; { const int q = nwg / NXCD, r = nwg % NXCD, xcd = wgid % NXCD, off = wgid / NXCD; wgid = (xcd < r ? xcd * (q + 1) : r * (q + 1) + (xcd - r) * q) + off; }
        const int nig = WGM * nN, gid = wgid / nig, fm = gid * WGM, gsz = (nM - fm) < WGM ? (nM - fm) : WGM;
        u.pm = fm + ((wgid % nig) % gsz); u.pn = (wgid % nig) / gsz; return true;
    }
};
template <class Prob>
DEV void gemm_phase(LAS unsigned char* lds, int tid, const StaticOrder& S, const Prob& P) {
    const int wid = __builtin_amdgcn_readfirstlane(tid >> 6), lane = tid & 63, wr = wid >> 2, wc = wid & 3, fr = lane & 15, fq = lane >> 4;
    const int nt = P.nt, lda = P.lda, ldb = P.ldb;
    unsigned voffA[2], voffB[2];
#pragma unroll
    for (int i = 0; i < 2; ++i) { int R, C; stage_rc(tid * 16 + i * 8192, R, C); const int Rb = (R & ~31) + perm32(R & 31);
        voffA[i] = (unsigned)(R * lda + C) * 2u; voffB[i] = (unsigned)(Rb * ldb + C) * 2u; }
    const size_t kstep = (size_t)(BK * 2);
    const size_t hstepA = (size_t)HALF * lda * 2, hstepB = (size_t)HALF * ldb * 2;
    const unsigned ldsw = (unsigned)wid * 1024u;
    const int aoff = lds_byte(wr * 64 + fr, fq * 8), boff = lds_byte(wc * 32 + fr, fq * 8);
#define PG8_SA(b, h) (((b) * 2 + (h)) * HTB)
#define PG8_SB(b, h) ((4 + (b) * 2 + (h)) * HTB)
#define PG8_STAGE(bufoff, gbase, voff) do { _Pragma("unroll") for (int _i = 0; _i < 2; ++_i) \
        __builtin_amdgcn_global_load_lds((const unsigned*)((const char*)(gbase) + (voff)[_i]), (LAS unsigned*)(lds + (bufoff) + ldsw + _i * 8192), 16, 0, 0); } while (0)
#define PG8_LDA(dst, b, h) do { _Pragma("unroll") for (int m = 0; m < 4; ++m) _Pragma("unroll") for (int k = 0; k < 2; ++k) dst[m][k] = *(const LAS bf16x8*)(lds + PG8_SA(b, h) + aoff + m * 2048 + k * 1024); } while (0)
#define PG8_LDB(dst, b, h) do { _Pragma("unroll") for (int n = 0; n < 2; ++n) _Pragma("unroll") for (int k = 0; k < 2; ++k) dst[n][k] = *(const LAS bf16x8*)(lds + PG8_SB(b, h) + boff + n * 2048 + k * 1024); } while (0)
#define PG8_MMA(ai, bj, At, Bt) do { __builtin_amdgcn_s_setprio(1); _Pragma("unroll") for (int m = 0; m < 4; ++m) _Pragma("unroll") for (int n = 0; n < 2; ++n) _Pragma("unroll") for (int k = 0; k < 2; ++k) \
        acc[ai][bj][m][n] = __builtin_amdgcn_mfma_f32_16x16x32_bf16(Bt[n][k], At[m][k], acc[ai][bj][m][n], 0, 0, 0); __builtin_amdgcn_s_setprio(0); } while (0)
#define PG8_WAIT_V(n) asm volatile("s_waitcnt vmcnt(" #n ")" ::: "memory")
#define PG8_WAIT_L(n) asm volatile("s_waitcnt lgkmcnt(" #n ")" ::: "memory")
#define PG8_BAR __builtin_amdgcn_s_barrier()
#define PG8_SCHED __builtin_amdgcn_sched_barrier(0)
    Unit cur, nxt; int ui = 0;
    if (!S.next(0, cur)) return;
    f32x4 acc[2][2][4][2];
#pragma unroll
    for (int a = 0; a < 2; ++a)
#pragma unroll
        for (int b = 0; b < 2; ++b)
#pragma unroll
            for (int m = 0; m < 4; ++m)
#pragma unroll
                for (int n = 0; n < 2; ++n) acc[a][b][m][n] = (f32x4){0.f, 0.f, 0.f, 0.f};
    bf16x8 At[4][2], B0[2][2], B1[2][2];
    const char* cA = P.aptr(cur); const char* cB = P.bptr(cur);
    PG8_STAGE(PG8_SB(0, 0), cB, voffB); PG8_STAGE(PG8_SA(0, 0), cA, voffA); PG8_STAGE(PG8_SB(0, 1), cB + hstepB, voffB); PG8_STAGE(PG8_SA(0, 1), cA + hstepA, voffA);
    if (wr == 1) PG8_BAR;
    PG8_WAIT_V(4); PG8_BAR;
    PG8_STAGE(PG8_SB(1, 0), cB + kstep, voffB); PG8_STAGE(PG8_SA(1, 0), cA + kstep, voffA); PG8_STAGE(PG8_SB(1, 1), cB + hstepB + kstep, voffB);
    PG8_WAIT_V(6); PG8_BAR;
    for (;;) {
        const bool has_next = S.next(ui + 1, nxt);
        const char* nA = has_next ? P.aptr(nxt) : cA; const char* nB = has_next ? P.bptr(nxt) : cB;
        for (int t = 0; t < nt; t += 2) {
            const bool last = (t == nt - 2);
            const char* a1 = cA + (size_t)(t + 1) * kstep;
            const char* a2 = last ? nA : cA + (size_t)(t + 2) * kstep; const char* b2 = last ? nB : cB + (size_t)(t + 2) * kstep;
            const char* a3 = a2 + kstep; const char* b3 = b2 + kstep;
            PG8_LDB(B0, 0, 0); PG8_SCHED; PG8_LDA(At, 0, 0); PG8_STAGE(PG8_SA(1, 1), a1 + hstepA, voffA);
            PG8_WAIT_L(8); PG8_BAR; PG8_WAIT_L(0); PG8_MMA(0, 0, At, B0); PG8_BAR; PG8_SCHED;
            PG8_LDB(B1, 0, 1); PG8_STAGE(PG8_SB(0, 0), b2, voffB);
            PG8_BAR; PG8_WAIT_L(0); PG8_MMA(0, 1, At, B1); PG8_BAR;
            PG8_LDA(At, 0, 1); PG8_STAGE(PG8_SA(0, 0), a2, voffA);
            PG8_BAR; PG8_WAIT_L(0); PG8_MMA(1, 0, At, B0); PG8_BAR; PG8_SCHED;
            PG8_STAGE(PG8_SB(0, 1), b2 + hstepB, voffB);
            PG8_WAIT_V(6); PG8_BAR; PG8_MMA(1, 1, At, B1); PG8_BAR;
            PG8_LDB(B0, 1, 0); PG8_SCHED; PG8_LDA(At, 1, 0); PG8_STAGE(PG8_SA(0, 1), a2 + hstepA, voffA);
            PG8_WAIT_L(8); PG8_BAR; PG8_WAIT_L(0); PG8_MMA(0, 0, At, B0); PG8_BAR; PG8_SCHED;
            PG8_LDB(B1, 1, 1); PG8_STAGE(PG8_SB(1, 0), b3, voffB);
            PG8_BAR; PG8_WAIT_L(0); PG8_MMA(0, 1, At, B1); PG8_BAR;
            PG8_LDA(At, 1, 1); PG8_STAGE(PG8_SA(1, 0), a3, voffA);
            PG8_BAR; PG8_WAIT_L(0); PG8_MMA(1, 0, At, B0); PG8_BAR; PG8_SCHED;
            PG8_STAGE(PG8_SB(1, 1), b3 + hstepB, voffB);
            PG8_WAIT_V(6); PG8_BAR; PG8_MMA(1, 1, At, B1); PG8_BAR;
        }
        P.epi(acc, cur, wr, wc, fr, fq);
        if (!has_next) break;
#pragma unroll
        for (int a = 0; a < 2; ++a)
#pragma unroll
            for (int b = 0; b < 2; ++b)
#pragma unroll
                for (int m = 0; m < 4; ++m)
#pragma unroll
                    for (int n = 0; n < 2; ++n) acc[a][b][m][n] = (f32x4){0.f, 0.f, 0.f, 0.f};
        cur = nxt; cA = nA; cB = nB; ++ui;
    }
    PG8_WAIT_V(0);
    if (wr == 0) PG8_BAR;
    PG8_BAR;
#undef PG8_SA
#undef PG8_SB
#undef PG8_STAGE
#undef PG8_LDA
#undef PG8_LDB
#undef PG8_MMA
#undef PG8_WAIT_V
#undef PG8_WAIT_L
#undef PG8_BAR
#undef PG8_SCHED
}
}
typedef f32x4 Acc[2][2][4][2];

DEV void st8(bf16_t* p, f32x4 a, f32x4 b) { u32x4 o; o.x = pk2(a[0], a[1]); o.y = pk2(a[2], a[3]); o.z = pk2(b[0], b[1]); o.w = pk2(b[2], b[3]); *(u32x4*)p = o; }
DEV float sq4(f32x4 a) { return a[0] * a[0] + a[1] * a[1] + a[2] * a[2] + a[3] * a[3]; }
DEV void rope8(f32x4& a, f32x4& b, const float* cosT, const float* sinT, int row, int fq) {
    const f32x4 c = *(const f32x4*)(cosT + (size_t)row * 16 + 4 * fq), s = *(const f32x4*)(sinT + (size_t)row * 16 + 4 * fq);
    const f32x4 x1 = a, x2 = b;
    a = x1 * c - x2 * s; b = x2 * c + x1 * s;
}

struct ProbPlain {
    const bf16_t* A; const bf16_t* Bt; int lda, ldb, nt;
    bf16_t* out; int ldo; bf16_t* out2; int split;
    const float* rs;
    int act;
    float* ssq; int nslot;
    DEV const char* aptr(const pg8::Unit& u) const { return (const char*)(A + (size_t)u.pm * 256 * lda); }
    DEV const char* bptr(const pg8::Unit& u) const { return (const char*)(Bt + (size_t)u.pn * 256 * ldb); }
    DEV void epi(const Acc& acc, const pg8::Unit& u, int wr, int wc, int fr, int fq) const {
        bf16_t* o = out; int pn = u.pn; if (pn >= split) { o = out2; pn -= split; }
#pragma unroll
        for (int ai = 0; ai < 2; ++ai)
#pragma unroll
            for (int m = 0; m < 4; ++m) {
                const int row = u.pm * 256 + ai * 128 + wr * 64 + m * 16 + fr;
                const float r = rs ? rs[row] : 1.f;
                float ss = 0.f;
#pragma unroll
                for (int bj = 0; bj < 2; ++bj) {
                    f32x4 v0 = acc[ai][bj][m][0] * r, v1 = acc[ai][bj][m][1] * r;
                    if (act == 1) {
#pragma unroll
                        for (int j = 0; j < 4; ++j) { float a = fmaxf(v0[j], 0.f), b = fmaxf(v1[j], 0.f); v0[j] = a * a; v1[j] = b * b; }
                    }
                    ss += sq4(v0) + sq4(v1);
                    st8(o + (size_t)row * ldo + pn * 256 + bj * 128 + wc * 32 + fq * 8, v0, v1);
                }
                if (ssq) { ss += __shfl_xor(ss, 16); ss += __shfl_xor(ss, 32); if (fq == 0) ssq[(size_t)row * nslot + u.pn * 4 + wc] = ss; }
            }
    }
};
struct ProbE1 {
    const bf16_t* A; const bf16_t* Bt; int lda, ldb, nt;
    bf16_t* proj; const float* rs; float* ssqq; float* ssqkv; const float* cosT; const float* sinT;
    DEV const char* aptr(const pg8::Unit& u) const { return (const char*)(A + (size_t)u.pm * 256 * lda); }
    DEV const char* bptr(const pg8::Unit& u) const { return (const char*)(Bt + (size_t)u.pn * 256 * ldb); }
    DEV void epi(const Acc& acc, const pg8::Unit& u, int wr, int wc, int fr, int fq) const {
#pragma unroll
        for (int ai = 0; ai < 2; ++ai)
#pragma unroll
            for (int m = 0; m < 4; ++m) {
                const int row = u.pm * 256 + ai * 128 + wr * 64 + m * 16 + fr;
                const float r = rs[row];
                float ss0 = 0.f, ss1 = 0.f;
#pragma unroll
                for (int bj = 0; bj < 2; ++bj) {
                    f32x4 v0 = acc[ai][bj][m][0] * r, v1 = acc[ai][bj][m][1] * r;
                    if (bj == 0) ss0 = sq4(v0) + sq4(v1); else ss1 = sq4(v0) + sq4(v1);
                    if (u.pn == 1 && bj == 1 && wc == 0) rope8(v0, v1, cosT, sinT, row, fq);
                    st8(proj + (size_t)row * 2048 + u.pn * 256 + bj * 128 + wc * 32 + fq * 8, v0, v1);
                }
                if (u.pn == 0) { float ss = ss0 + ss1; ss += __shfl_xor(ss, 16); ss += __shfl_xor(ss, 32); if (fq == 0) ssqq[(size_t)row * 4 + wc] = ss; }
                if (u.pn == 1) { float ss = ss0; ss += __shfl_xor(ss, 16); ss += __shfl_xor(ss, 32); if (fq == 0) ssqkv[(size_t)row * 4 + wc] = ss; }
            }
    }
};
struct ProbE2 {
    const bf16_t* proj; const bf16_t* Wuq; const bf16_t* Wukv; int lda, ldb, nt;
    bf16_t* Q; bf16_t* KN; bf16_t* V; const float* ssqq; const float* ssqkv; const float* cosT; const float* sinT;
    DEV const char* aptr(const pg8::Unit& u) const { return (const char*)(proj + (size_t)u.pm * 256 * 2048 + (u.pn < 3 ? PJ_CQ : PJ_CKV)); }
    DEV const char* bptr(const pg8::Unit& u) const { return (const char*)(u.pn < 3 ? Wuq + (size_t)u.pn * 256 * 256 : Wukv + (size_t)(u.pn - 3) * 256 * 256); }
    DEV void epi(const Acc& acc, const pg8::Unit& u, int wr, int wc, int fr, int fq) const {
        const bool isq = u.pn < 3; const int t = u.pn - 3;
#pragma unroll
        for (int ai = 0; ai < 2; ++ai)
#pragma unroll
            for (int m = 0; m < 4; ++m) {
                const int row = u.pm * 256 + ai * 128 + wr * 64 + m * 16 + fr;
                const f32x4 p4 = *(const f32x4*)((isq ? ssqq : ssqkv) + (size_t)row * 4);
                const float r = rsqrtf(((p4[0] + p4[1]) + (p4[2] + p4[3])) * (isq ? (1.f / 256.f) : (1.f / 128.f)) + EPS);
#pragma unroll
                for (int bj = 0; bj < 2; ++bj) {
                    f32x4 v0 = acc[ai][bj][m][0] * r, v1 = acc[ai][bj][m][1] * r;
                    if (isq) {
                        const int g32 = u.pn * 8 + bj * 4 + wc;
                        if (g32 % 3 == 2) rope8(v0, v1, cosT, sinT, row, fq);
                        st8(Q + (size_t)row * 768 + u.pn * 256 + bj * 128 + wc * 32 + fq * 8, v0, v1);
                    } else {
                        bf16_t* o = (t < 2) ? KN : V;
                        st8(o + (size_t)row * 512 + (t & 1) * 256 + bj * 128 + wc * 32 + fq * 8, v0, v1);
                    }
                }
            }
    }
};


struct ProbKV {
    const bf16_t* memn; const bf16_t* xkt; int lda, ldb, nt; bf16_t* KX; bf16_t* VX;
    DEV const char* aptr(const pg8::Unit& u) const { return (const char*)(memn + (size_t)(u.pn >> 3) * 256 * 1024); }
    DEV const char* bptr(const pg8::Unit& u) const { return (const char*)(xkt + ((size_t)(u.pn >> 2) * 1024 + (u.pn & 3) * 256) * 1024); }
    DEV void epi(const Acc& acc, const pg8::Unit& u, int wr, int wc, int fr, int fq) const {
        bf16_t* o = (((u.pn >> 2) & 1) ? VX : KX) + (size_t)(u.pn >> 3) * 256 * 1024;
#pragma unroll
        for (int ai = 0; ai < 2; ++ai)
#pragma unroll
            for (int m = 0; m < 4; ++m) {
                const int row = ai * 128 + wr * 64 + m * 16 + fr;
#pragma unroll
                for (int bj = 0; bj < 2; ++bj) st8(o + (size_t)row * 1024 + (u.pn & 3) * 256 + bj * 128 + wc * 32 + fq * 8, acc[ai][bj][m][0], acc[ai][bj][m][1]);
            }
    }
};

DEV bf16x8 tr_frag(const LAS unsigned char* blk_ks_base, int lane) {
    const int hi = lane >> 5;
    const LAS unsigned char* p = blk_ks_base + ((lane >> 4) & 1) * 32 + (lane & 3) * 8 + (4 * hi + ((lane & 15) >> 2)) * 64;
    const s16x4 lo = __builtin_bit_cast(s16x4, __builtin_amdgcn_ds_read_tr16_b64_v4i16((LAS v4i16_t*)p));
    const s16x4 hh = __builtin_bit_cast(s16x4, __builtin_amdgcn_ds_read_tr16_b64_v4i16((LAS v4i16_t*)(p + 512)));
    return (bf16x8){lo[0], lo[1], lo[2], lo[3], hh[0], hh[1], hh[2], hh[3]};
}
DEV bf16x8 pack8(const f32x16& p, int b) {
    u32x4 o; o.x = pk2(p[b], p[b + 1]); o.y = pk2(p[b + 2], p[b + 3]); o.z = pk2(p[b + 4], p[b + 5]); o.w = pk2(p[b + 6], p[b + 7]);
    return __builtin_bit_cast(bf16x8, o);
}
template <int NC1, int NC2, int NVB, int NDVB, bool CAUSAL>
DEV void flash_unit(const Ctx& c, const bf16_t* Qw, int ldq, const bf16_t* K1, int ldk1, const bf16_t* K2, int ldk2, const bf16_t* Vp, int ldv,
                    bf16_t* Ow, int ldo, int NT, int dvb0, int qrel0, int band0) {
    constexpr int NCH = NC1 + NC2, NKD = NCH / 2, KB = NCH * 1024, VB = NVB * 4096, BUF = KB + VB;
    constexpr int NKP = 64 * NCH, KPT = (NKP + 511) / 512, NVP = 256 * NVB, VPT = (NVP + 511) / 512;
    const int tid = c.tid, lane = c.lane, r32 = lane & 31, hi = lane >> 5;
    LAS unsigned char* lds = c.lds;
    bf16x8 qr[NKD];
#pragma unroll
    for (int d0 = 0; d0 < NKD; ++d0) qr[d0] = *(const bf16x8*)(Qw + (size_t)r32 * ldq + d0 * 16 + hi * 8);
    auto g_load = [&](int t, int buf) {
        LAS unsigned char* kb = lds + buf * BUF; LAS unsigned char* vb = kb + KB;
#pragma unroll
        for (int i = 0; i < KPT; ++i) { const int p = tid + 512 * i;
            if (p < NKP) { const int ch = p >> 6, row = t * 64 + (p & 63);
                const bf16_t* src = (ch < NC1) ? K1 + (size_t)row * ldk1 + ch * 8 : K2 + (size_t)row * ldk2 + (ch - NC1) * 8;
                __builtin_amdgcn_global_load_lds((const unsigned*)src, (LAS unsigned*)(kb + (c.wave * 64 + 512 * i) * 16), 16, 0, 0); } }
#pragma unroll
        for (int i = 0; i < VPT; ++i) { const int p = tid + 512 * i;
            if (p < NVP) { const int blk = p >> 8, row = t * 64 + ((p >> 2) & 63), c4 = p & 3;
                __builtin_amdgcn_global_load_lds((const unsigned*)(Vp + (size_t)row * ldv + blk * 32 + c4 * 8), (LAS unsigned*)(vb + (c.wave * 64 + 512 * i) * 16), 16, 0, 0); } }
    };
    float m_run = -INFINITY, l_run = 0.f;
    f32x16 oT[NDVB];
#pragma unroll
    for (int b = 0; b < NDVB; ++b)
#pragma unroll
        for (int r = 0; r < 16; ++r) oT[b][r] = 0.f;
    g_load(0, 0); __syncthreads();
    for (int t = 0; t < NT; ++t) {
        const int buf = t & 1;
        if (t + 1 < NT) g_load(t + 1, buf ^ 1);
        bool active = true;
        if (CAUSAL) { const int jb = t - band0; if (jb >= 0 && 64 * jb > qrel0 + 31) active = false; }
        if (active) {
            const LAS unsigned char* Kb = lds + buf * BUF; const LAS unsigned char* Vb = Kb + KB;
            f32x16 p0, p1;
#pragma unroll
            for (int r = 0; r < 16; ++r) { p0[r] = 0.f; p1[r] = 0.f; }
#pragma unroll
            for (int d0 = 0; d0 < NKD; ++d0) {
                const bf16x8 k0 = *(const LAS bf16x8*)(Kb + (2 * d0 + hi) * 1024 + r32 * 16);
                const bf16x8 k1 = *(const LAS bf16x8*)(Kb + (2 * d0 + hi) * 1024 + r32 * 16 + 512);
                p0 = __builtin_amdgcn_mfma_f32_32x32x16_bf16(k0, qr[d0], p0, 0, 0, 0);
                p1 = __builtin_amdgcn_mfma_f32_32x32x16_bf16(k1, qr[d0], p1, 0, 0, 0);
            }
            if (CAUSAL) { const int jb = t - band0;
                if (jb >= 0) { const int qrel = qrel0 + r32, kb = 64 * jb + 4 * hi;
#pragma unroll
                    for (int r = 0; r < 16; ++r) { const int kv = kb + (r & 3) + 8 * (r >> 2); if (kv > qrel) p0[r] = -INFINITY; if (kv + 32 > qrel) p1[r] = -INFINITY; } } }
            float mx = fmaxf(p0[0], p1[0]);
#pragma unroll
            for (int r = 1; r < 16; ++r) mx = fmaxf(mx, fmaxf(p0[r], p1[r]));
            mx = swap32_max(mx);
            const float mnew = fmaxf(m_run, mx);
            const float alpha = __builtin_amdgcn_exp2f(m_run - mnew);
            float ps = 0.f;
#pragma unroll
            for (int r = 0; r < 16; ++r) { p0[r] = __builtin_amdgcn_exp2f(p0[r] - mnew); p1[r] = __builtin_amdgcn_exp2f(p1[r] - mnew); ps += p0[r] + p1[r]; }
            l_run = l_run * alpha + ps; m_run = mnew;
#pragma unroll
            for (int b = 0; b < NDVB; ++b)
#pragma unroll
                for (int r = 0; r < 16; ++r) oT[b][r] *= alpha;
            bf16x8 pw[4]; pw[0] = pack8(p0, 0); pw[1] = pack8(p0, 8); pw[2] = pack8(p1, 0); pw[3] = pack8(p1, 8);
#pragma unroll
            for (int b = 0; b < NDVB; ++b)
#pragma unroll
                for (int ks = 0; ks < 4; ++ks) {
                    const bf16x8 vf = tr_frag(Vb + (dvb0 + b) * 4096 + ks * 1024, lane);
                    oT[b] = __builtin_amdgcn_mfma_f32_32x32x16_bf16(vf, pw[ks], oT[b], 0, 0, 0);
                }
        }
        __syncthreads();
    }
    const float inv = 1.f / swap32_sum(l_run);
#pragma unroll
    for (int b = 0; b < NDVB; ++b)
#pragma unroll
        for (int g = 0; g < 4; ++g) {
            u32x2 o; o.x = pk2(oT[b][4 * g] * inv, oT[b][4 * g + 1] * inv); o.y = pk2(oT[b][4 * g + 2] * inv, oT[b][4 * g + 3] * inv);
            *(u32x2*)(Ow + (size_t)r32 * ldo + b * 32 + 8 * g + 4 * hi) = o;
        }
}


DEV float gla_cumdecay(const Ctx& c, const bf16_t* PJ, const float* wg, const float* bg, int t0, int head, LAS float* Bm, LAS float* tot, float (&bl)[8]) {
    const int ch = c.lane, w = c.wave;
    float wcol[16];
#pragma unroll
    for (int j = 0; j < 16; ++j) wcol[j] = wg[j * 256 + head * 64 + ch];
    const float bias = bg[head * 64 + ch];
    float run = 0.f;
#pragma unroll
    for (int i = 0; i < 8; ++i) {
        const bf16_t* gl = PJ + (size_t)(t0 + 8 * w + i) * 2048 + PJ_GLR;
        float x = bias;
#pragma unroll
        for (int j = 0; j < 16; ++j) x += bf1(gl[j]) * wcol[j];
        run += logsigmoid_f(x) * (1.f / 16.f);
        bl[i] = run;
    }
    tot[w * 64 + ch] = run;
    __syncthreads();
    float off = 0.f, bend = 0.f;
#pragma unroll
    for (int ww = 0; ww < 8; ++ww) { const float tv = tot[ww * 64 + ch]; if (ww < w) off += tv; bend += tv; }
#pragma unroll
    for (int i = 0; i < 8; ++i) { bl[i] += off; Bm[(8 * w + i) * 64 + ch] = bl[i]; }
    return bend;
}
constexpr int GL_BM = 0, GL_TOT = 16384, GL_QI = 20480, GL_KI = 28672, GL_VI = 36864, GL_RED = 53248;
DEV void gla_load_v(const Ctx& c, const bf16_t* PJ, int t0, int head, LAS unsigned char* VI) {
#pragma unroll
    for (int i = 0; i < 2; ++i) { const int p = c.tid + 512 * i, blk = p >> 8, row = (p >> 2) & 63, c4 = p & 3;
        *(LAS u32x4*)(VI + p * 16) = *(const u32x4*)(PJ + (size_t)(t0 + row) * 2048 + PJ_GV + head * 128 + blk * 32 + c4 * 8); }
}
DEV void gla_a_unit(const Ctx& c, const bf16_t* PJ, const float* wg, const float* bg, int cidx, int head, bf16_t* GST, float* GDEC) {
    LAS unsigned char* lds = c.lds; const int t0 = cidx * 64, ch = c.lane, w = c.wave;
    float bl[8];
    const float bend = gla_cumdecay(c, PJ, wg, bg, t0, head, (LAS float*)(lds + GL_BM), (LAS float*)(lds + GL_TOT), bl);
#pragma unroll
    for (int i = 0; i < 8; ++i) { const int t = 8 * w + i;
        const float kv = bf1(PJ[(size_t)(t0 + t) * 2048 + PJ_GK + head * 64 + ch]) * __expf(bend - bl[i]);
        *(LAS bf16_t*)(lds + GL_KI + (ch >> 5) * 4096 + t * 64 + (ch & 31) * 2) = f2bf(kv); }
    gla_load_v(c, PJ, t0, head, lds + GL_VI);
    if (w == 0) GDEC[(cidx * 4 + head) * 64 + ch] = __expf(bend);
    __syncthreads();
    const int dvb = w >> 1, dkb = w & 1, r32 = c.lane & 31, hi = c.lane >> 5;
    f32x16 acc;
#pragma unroll
    for (int r = 0; r < 16; ++r) acc[r] = 0.f;
#pragma unroll
    for (int ks = 0; ks < 4; ++ks) {
        const bf16x8 a = tr_frag(lds + GL_VI + dvb * 4096 + ks * 1024, c.lane), b = tr_frag(lds + GL_KI + dkb * 4096 + ks * 1024, c.lane);
        acc = __builtin_amdgcn_mfma_f32_32x32x16_bf16(a, b, acc, 0, 0, 0);
    }
    bf16_t* o = GST + ((size_t)(cidx * 4 + head) * 128 + dvb * 32) * 64 + dkb * 32 + r32;
#pragma unroll
    for (int r = 0; r < 16; ++r) o[(size_t)crow(r, hi) * 64] = f2bf(acc[r]);
    __syncthreads();
}
DEV void gla_scan(const Ctx& c, bf16_t* GST, const float* GDEC) {
    const int e = c.vcu * NTHREADS + c.tid;
    if (e >= 4 * 128 * 64) return;
    const int hh = e >> 13, dk = e & 63, rem = e & 8191;
    float st = 0.f;
    for (int cb = 0; cb < 256; cb += 8) {
        float u[8], a[8];
#pragma unroll
        for (int i = 0; i < 8; ++i) { u[i] = bf1(GST[(size_t)((cb + i) * 4 + hh) * 8192 + rem]); a[i] = GDEC[((cb + i) * 4 + hh) * 64 + dk]; }
#pragma unroll
        for (int i = 0; i < 8; ++i) { GST[(size_t)((cb + i) * 4 + hh) * 8192 + rem] = f2bf(st); st = a[i] * st + u[i]; }
    }
}
DEV void gla_c_unit(const Ctx& c, const bf16_t* PJ, const float* wg, const float* bg, const float* gnorm, int cidx, int head, const bf16_t* GST, bf16_t* CAT) {
    LAS unsigned char* lds = c.lds; const int t0 = cidx * 64, ch = c.lane, w = c.wave;
    float bl[8];
    (void)gla_cumdecay(c, PJ, wg, bg, t0, head, (LAS float*)(lds + GL_BM), (LAS float*)(lds + GL_TOT), bl);
#pragma unroll
    for (int i = 0; i < 8; ++i) { const int t = 8 * w + i;
        const float qv = bf1(PJ[(size_t)(t0 + t) * 2048 + PJ_GQ + head * 64 + ch]) * __expf(bl[i]) * 0.125f;
        const float kv = bf1(PJ[(size_t)(t0 + t) * 2048 + PJ_GK + head * 64 + ch]) * __expf(fminf(-bl[i], 60.f));
        *(LAS bf16_t*)(lds + GL_QI + (ch >> 3) * 1024 + t * 16 + (ch & 7) * 2) = f2bf(qv);
        *(LAS bf16_t*)(lds + GL_KI + (ch >> 3) * 1024 + t * 16 + (ch & 7) * 2) = f2bf(kv); }
    gla_load_v(c, PJ, t0, head, lds + GL_VI);
    __syncthreads();
    const int dvb = w >> 1, tb = w & 1, r32 = c.lane & 31, hi = c.lane >> 5;
    bf16x8 qf[4];
#pragma unroll
    for (int d0 = 0; d0 < 4; ++d0) qf[d0] = *(const LAS bf16x8*)(lds + GL_QI + (2 * d0 + hi) * 1024 + (tb * 32 + r32) * 16);
    bf16x8 pw[4];
#pragma unroll
    for (int sb = 0; sb < 2; ++sb) {
        f32x16 aT;
#pragma unroll
        for (int r = 0; r < 16; ++r) aT[r] = 0.f;
        if (sb <= tb) {
#pragma unroll
            for (int d0 = 0; d0 < 4; ++d0) {
                const bf16x8 kf = *(const LAS bf16x8*)(lds + GL_KI + (2 * d0 + hi) * 1024 + (sb * 32 + r32) * 16);
                aT = __builtin_amdgcn_mfma_f32_32x32x16_bf16(kf, qf[d0], aT, 0, 0, 0);
            }
            if (sb == tb) {
#pragma unroll
                for (int r = 0; r < 16; ++r) if (crow(r, hi) > r32) aT[r] = 0.f;
            }
        }
        pw[2 * sb] = pack8(aT, 0); pw[2 * sb + 1] = pack8(aT, 8);
    }
    f32x16 oT;
#pragma unroll
    for (int r = 0; r < 16; ++r) oT[r] = 0.f;
#pragma unroll
    for (int ks = 0; ks < 4; ++ks) {
        if (ks < 2 * (tb + 1)) { const bf16x8 vf = tr_frag(lds + GL_VI + dvb * 4096 + ks * 1024, c.lane); oT = __builtin_amdgcn_mfma_f32_32x32x16_bf16(vf, pw[ks], oT, 0, 0, 0); }
    }
    const bf16_t* stp = GST + ((size_t)(cidx * 4 + head) * 128 + dvb * 32 + r32) * 64 + hi * 8;
#pragma unroll
    for (int d0 = 0; d0 < 4; ++d0) { const bf16x8 sf = *(const bf16x8*)(stp + d0 * 16); oT = __builtin_amdgcn_mfma_f32_32x32x16_bf16(sf, qf[d0], oT, 0, 0, 0); }
    float my = 0.f;
#pragma unroll
    for (int r = 0; r < 16; ++r) my += oT[r] * oT[r];
    my = swap32_sum(my);
    LAS float* red = (LAS float*)(lds + GL_RED);
    if (hi == 0) red[dvb * 64 + tb * 32 + r32] = my;
    __syncthreads();
    const int t = tb * 32 + r32;
    const float rs = rsqrtf((red[t] + red[64 + t] + red[128 + t] + red[192 + t]) * (1.f / 128.f) + EPS);
#pragma unroll
    for (int g = 0; g < 4; ++g) {
        const int dv = dvb * 32 + 8 * g + 4 * hi;
        const u32x2 rr = *(const u32x2*)(PJ + (size_t)(t0 + t) * 2048 + PJ_R + head * 128 + dv);
        const f32x4 gn = *(const f32x4*)(gnorm + dv);
        const float v0 = oT[4 * g] * rs * gn[0] * silu_f(bflo(rr.x)), v1 = oT[4 * g + 1] * rs * gn[1] * silu_f(bfhi(rr.x));
        const float v2 = oT[4 * g + 2] * rs * gn[2] * silu_f(bflo(rr.y)), v3 = oT[4 * g + 3] * rs * gn[3] * silu_f(bfhi(rr.y));
        u32x2 o; o.x = pk2(v0, v1); o.y = pk2(v2, v3);
        *(u32x2*)(CAT + (size_t)(t0 + t) * 1024 + 512 + head * 128 + dv) = o;
    }
    __syncthreads();
}


DEV void conv_phase(const Ctx& c, const bf16_t* XM, const float* convw, const float* convb, const float* G12  , const float* bgates,
                    bf16_t* XC, float* gates) {
    LAS float* gl = (LAS float*)c.lds;
    for (int i = c.tid; i < 16 * 1024 / 4; i += NTHREADS) *(LAS f32x4*)(gl + 4 * i) = *(const f32x4*)(G12 + 4 * i);
    __syncthreads();
    for (int blk = c.gw; blk < S / 8; blk += c.NGW) {
        const int t0 = blk * 8;
        float ga[8][8];
#pragma unroll
        for (int rr = 0; rr < 8; ++rr)
#pragma unroll
            for (int g = 0; g < 8; ++g) ga[rr][g] = 0.f;
#pragma unroll 1
        for (int j = 0; j < 4; ++j) {
            const int ch = 4 * c.lane + 256 * j;
            const f32x4 cb = *(const f32x4*)(convb + ch);
            f32x4 cw[4];
#pragma unroll
            for (int i = 0; i < 4; ++i) cw[i] = *(const f32x4*)(convw + i * 1024 + ch);
            f32x4 w1[8], w2[8];
#pragma unroll
            for (int g = 0; g < 8; ++g) { w1[g] = *(const LAS f32x4*)(gl + g * 1024 + ch); w2[g] = *(const LAS f32x4*)(gl + (8 + g) * 1024 + ch); }
            f32x4 win[4];
#pragma unroll
            for (int i = 0; i < 3; ++i) {
                const int t = t0 - 3 + i;
                if (t >= 0) { const u32x2 mm = *(const u32x2*)(XM + (size_t)t * 1024 + ch); win[i] = (f32x4){bflo(mm.x), bfhi(mm.x), bflo(mm.y), bfhi(mm.y)}; }
                else win[i] = (f32x4){0.f, 0.f, 0.f, 0.f};
            }
#pragma unroll
            for (int rr = 0; rr < 8; ++rr) {
                const int t = t0 + rr;
                const u32x2 mm = *(const u32x2*)(XM + (size_t)t * 1024 + ch);
                win[3] = (f32x4){bflo(mm.x), bfhi(mm.x), bflo(mm.y), bfhi(mm.y)};
                const f32x4 y = cb + cw[0] * win[0] + cw[1] * win[1] + cw[2] * win[2] + cw[3] * win[3];
                f32x4 xc;
#pragma unroll
                for (int e = 0; e < 4; ++e) xc[e] = y[e] / (1.f + __expf(-y[e]));
                u32x2 o; o.x = pk2(xc[0], xc[1]); o.y = pk2(xc[2], xc[3]);
                *(u32x2*)(XC + (size_t)t * 1024 + ch) = o;
#pragma unroll
                for (int g = 0; g < 8; ++g)
                    ga[rr][g] += xc[0] * w1[g][0] + xc[1] * w1[g][1] + xc[2] * w1[g][2] + xc[3] * w1[g][3] + win[3][0] * w2[g][0] + win[3][1] * w2[g][1] + win[3][2] * w2[g][2] + win[3][3] * w2[g][3];
                win[0] = win[1]; win[1] = win[2]; win[2] = win[3];
            }
        }
#pragma unroll
        for (int rr = 0; rr < 8; ++rr) {
            float v = 0.f;
#pragma unroll
            for (int g = 0; g < 8; ++g) { const float sg = wave_sum(ga[rr][g]); if (c.lane == g) v = sg; }
            if (c.lane < 8) gates[(size_t)(t0 + rr) * 8 + c.lane] = v + bgates[c.lane];
        }
    }
    __syncthreads();
}
DEV void gatefold_job(const Ctx& c, const float* wq, const float* wk, const float* wv, const float* Wg, float* G12) {
    for (int i = c.gw * 64 + c.lane; i < 16 * 1024; i += c.NGW * 64) {
        const int g16 = i >> 10, ch = i & 1023, hh = ch >> 8, d = ch & 255, g = g16 & 7;
        float acc = 0.f;
        if (g16 < 8) { const float* a = wq + ((size_t)hh * 256 + d) * 256; const float* b = wk + ((size_t)hh * 256 + d) * 256;
            for (int e = 0; e < 256; ++e) acc += a[e] * Wg[(size_t)(hh * 768 + e) * 8 + g] + b[e] * Wg[(size_t)(hh * 768 + 256 + e) * 8 + g]; }
        else { const float* a = wv + ((size_t)hh * 256 + d) * 256;
            for (int e = 0; e < 256; ++e) acc += a[e] * Wg[(size_t)(hh * 768 + 512 + e) * 8 + g]; }
        G12[i] = acc;
    }
}
struct ProbO3 {
    const bf16_t* XC; const bf16_t* XM; const bf16_t* W3; int lda, ldb, nt; bf16_t* MQ; bf16_t* MK; bf16_t* MV;
    DEV const char* aptr(const pg8::Unit& u) const { return (const char*)(((u.pn >> 2) == 2 ? XM : XC) + (size_t)u.pm * 256 * 1024 + (u.pn & 3) * 256); }
    DEV const char* bptr(const pg8::Unit& u) const { return (const char*)(W3 + (size_t)u.pn * 65536); }
    DEV void epi(const Acc& acc, const pg8::Unit& u, int wr, int wc, int fr, int fq) const {
        const int which = u.pn >> 2; bf16_t* o = MQ + (size_t)which * (16u << 20) + (u.pn & 3) * 256;
#pragma unroll
        for (int ai = 0; ai < 2; ++ai)
#pragma unroll
            for (int m = 0; m < 4; ++m) {
                const int row = u.pm * 256 + ai * 128 + wr * 64 + m * 16 + fr;
#pragma unroll
                for (int bj = 0; bj < 2; ++bj) st8(o + (size_t)row * 1024 + bj * 128 + wc * 32 + fq * 8, acc[ai][bj][m][0], acc[ai][bj][m][1]);
            }
    }
};


constexpr int ML_ARR = 131072, ML_BT = ML_ARR, ML_GT = ML_ARR + 1024, ML_CM = ML_ARR + 2048, ML_WT = ML_ARR + 3072, ML_SCR = ML_ARR + 4096, ML_LN = ML_ARR + 4352;
constexpr size_t ML_MSTAT_G = 0, ML_MSTAT_M = 4096, ML_NLOC = 8192;
DEV void mlstm_tokens(const Ctx& c, const float* gates, int t0, int head, float m_in, float& bend, float& gmax) {
    LAS float* Bt = (LAS float*)(c.lds + ML_BT); LAS float* Gt = (LAS float*)(c.lds + ML_GT); LAS float* CMt = (LAS float*)(c.lds + ML_CM); LAS float* scr = (LAS float*)(c.lds + ML_SCR);
    const int tid = c.tid, lane = c.lane, w = c.wave; const bool act = tid < 256;
    float v = act ? logsigmoid_f(gates[(size_t)(t0 + tid) * 8 + 4 + head]) : 0.f;
    const float ii = act ? gates[(size_t)(t0 + tid) * 8 + head] : 0.f;
#pragma unroll
    for (int o = 1; o < 64; o <<= 1) { const float t = __shfl_up(v, o); if (lane >= o) v += t; }
    if (lane == 63 && w < 4) scr[w] = v;
    __syncthreads();
    float off = 0.f;
#pragma unroll
    for (int ww = 0; ww < 4; ++ww) if (ww < w) off += scr[ww];
    const float b = v + off, g = ii - b;
    float mx = g;
#pragma unroll
    for (int o = 1; o < 64; o <<= 1) { const float t = __shfl_up(mx, o); if (lane >= o) mx = fmaxf(mx, t); }
    if (lane == 63 && w < 4) scr[8 + w] = mx;
    __syncthreads();
    float pm = m_in;
#pragma unroll
    for (int ww = 0; ww < 4; ++ww) if (ww < w) pm = fmaxf(pm, scr[8 + ww]);
    if (act) { Bt[tid] = b; Gt[tid] = g; CMt[tid] = fmaxf(mx, pm); }
    bend = (scr[0] + scr[1]) + (scr[2] + scr[3]); gmax = fmaxf(fmaxf(scr[8], scr[9]), fmaxf(scr[10], scr[11]));
    __syncthreads();
}
DEV void mlstm_a_unit(const Ctx& c, const float* gates, const bf16_t* MK, const bf16_t* MV, int cidx, int head, bf16_t* CST, float* MST) {
    LAS unsigned char* lds = c.lds; const int t0 = cidx * 256, tid = c.tid, lane = c.lane, w = c.wave, r32 = lane & 31, hi = lane >> 5;
    float bend, G;
    mlstm_tokens(c, gates, t0, head, -INFINITY, bend, G);
    LAS float* Gt = (LAS float*)(lds + ML_GT); LAS float* Wt = (LAS float*)(lds + ML_WT);
    if (tid < 256) Wt[tid] = __expf(Gt[tid] - G);
    if (tid == 0) { MST[ML_MSTAT_G + (cidx * 4 + head) * 2] = G; MST[ML_MSTAT_G + (cidx * 4 + head) * 2 + 1] = bend; }
    const int dvb0 = (w >> 1) * 2, dkb0 = (w & 1) * 4;
    f32x16 acc[2][4];
#pragma unroll
    for (int i = 0; i < 2; ++i)
#pragma unroll
        for (int jj = 0; jj < 4; ++jj)
#pragma unroll
            for (int r = 0; r < 16; ++r) acc[i][jj][r] = 0.f;
    float nl = 0.f;
    for (int kt = 0; kt < 4; ++kt) {
        __syncthreads();
#pragma unroll 1
        for (int i = 0; i < 4; ++i) {
            const int p = tid + 512 * i, blk = p >> 8, row = (p >> 2) & 63, c4 = p & 3;
            const size_t go = (size_t)(t0 + 64 * kt + row) * 1024 + head * 256 + blk * 32 + c4 * 8;
            __builtin_amdgcn_global_load_lds((const unsigned*)(MV + go), (LAS unsigned*)(lds + (w * 64 + 512 * i) * 16), 16, 0, 0);
            const u32x4 kk = *(const u32x4*)(MK + go);
            const float ws = Wt[64 * kt + row];
            u32x4 o; o.x = pk2(bflo(kk.x) * ws, bfhi(kk.x) * ws); o.y = pk2(bflo(kk.y) * ws, bfhi(kk.y) * ws); o.z = pk2(bflo(kk.z) * ws, bfhi(kk.z) * ws); o.w = pk2(bflo(kk.w) * ws, bfhi(kk.w) * ws);
            *(LAS u32x4*)(lds + 32768 + p * 16) = o;
        }
        __syncthreads();
#pragma unroll
        for (int ks = 0; ks < 4; ++ks) {
            bf16x8 a[2], b[4];
#pragma unroll
            for (int i = 0; i < 2; ++i) a[i] = tr_frag(lds + (dvb0 + i) * 4096 + ks * 1024, lane);
#pragma unroll
            for (int jj = 0; jj < 4; ++jj) b[jj] = tr_frag(lds + 32768 + (dkb0 + jj) * 4096 + ks * 1024, lane);
#pragma unroll
            for (int i = 0; i < 2; ++i)
#pragma unroll
                for (int jj = 0; jj < 4; ++jj) acc[i][jj] = __builtin_amdgcn_mfma_f32_32x32x16_bf16(a[i], b[jj], acc[i][jj], 0, 0, 0);
        }
        if (tid < 256) { const LAS bf16_t* kc = (const LAS bf16_t*)(lds + 32768 + (tid >> 5) * 4096 + (tid & 31) * 2);
            for (int row = 0; row < 64; ++row) nl += bf1(kc[row * 32]); }
    }
    bf16_t* o = CST + (size_t)(cidx * 4 + head) * 65536;
#pragma unroll
    for (int i = 0; i < 2; ++i)
#pragma unroll
        for (int jj = 0; jj < 4; ++jj)
#pragma unroll
            for (int r = 0; r < 16; ++r) o[(size_t)((dvb0 + i) * 32 + crow(r, hi)) * 256 + (dkb0 + jj) * 32 + r32] = f2bf(acc[i][jj][r]);
    if (tid < 256) MST[ML_NLOC + (size_t)(cidx * 4 + head) * 256 + tid] = nl;
    __syncthreads();
}
DEV void mlstm_scan(const Ctx& c, bf16_t* CST, float* MST) {
    const int gidx = c.vcu * NTHREADS + c.tid;
#pragma unroll 1
    for (int rep = 0; rep < 3; ++rep) {
        const int e = rep < 2 ? gidx + rep * 131072 : gidx;
        if (rep == 2 && gidx >= 1024) break;
        if (rep < 2 && e >= 262144) continue;
        const int hh = rep < 2 ? (e >> 16) : (e >> 8); const int el = rep < 2 ? (e & 65535) : (e & 255);
        float m = 0.f, st = 0.f;
        for (int cb = 0; cb < 63; cb += 7) {
            float u[7], G[7], be[7];
#pragma unroll
            for (int i = 0; i < 7; ++i) { const int ci = (cb + i) * 4 + hh;
                u[i] = rep < 2 ? bf1(CST[(size_t)ci * 65536 + el]) : MST[ML_NLOC + (size_t)ci * 256 + el];
                G[i] = MST[ML_MSTAT_G + ci * 2]; be[i] = MST[ML_MSTAT_G + ci * 2 + 1]; }
#pragma unroll
            for (int i = 0; i < 7; ++i) { const int ci = (cb + i) * 4 + hh;
                const float M = fmaxf(m, G[i]);
                st = __expf(m - M) * st + __expf(G[i] - M) * u[i];
                m = be[i] + M;
                if (rep < 2) CST[(size_t)ci * 65536 + el] = f2bf(st); else MST[ML_NLOC + (size_t)ci * 256 + el] = st;
                if (rep == 2 && el == 0) MST[ML_MSTAT_M + ci] = m; }
        }
    }
}
DEV void mlstm_c_unit(const Ctx& c, const float* gates, const bf16_t* MQ, const bf16_t* MK, const bf16_t* MV, const bf16_t* CST, const float* MST,
                      const bf16_t* XC, const bf16_t* Z, const float* ghn, const float* skip, bf16_t* OUTM, int cidx, int head, int rhf) {
    constexpr int KB = 32768, BUF = 65536;
    LAS unsigned char* lds = c.lds; const int t0 = cidx * 256, tid = c.tid, lane = c.lane, w = c.wave, r32 = lane & 31, hi = lane >> 5;
    const int rg = w >> 1, dvh = w & 1;
    const float m_in = cidx > 0 ? MST[ML_MSTAT_M + (cidx - 1) * 4 + head] : 0.f;
    float bend, gmx;
    mlstm_tokens(c, gates, t0, head, m_in, bend, gmx);
    LAS float* Bt = (LAS float*)(lds + ML_BT); LAS float* Gt = (LAS float*)(lds + ML_GT); LAS float* CMt = (LAS float*)(lds + ML_CM); LAS float* Nt = (LAS float*)(lds + ML_WT);
    if (tid < 256) Nt[tid] = cidx > 0 ? MST[ML_NLOC + (size_t)((cidx - 1) * 4 + head) * 256 + tid] : 0.f;
    auto g_load = [&](int kt, int buf) {
        LAS unsigned char* kb = lds + buf * BUF; LAS unsigned char* vb = kb + KB;
#pragma unroll
        for (int i = 0; i < 4; ++i) { const int p = tid + 512 * i;
            { const int ch = p >> 6, row = t0 + kt * 64 + (p & 63);
              __builtin_amdgcn_global_load_lds((const unsigned*)(MK + (size_t)row * 1024 + head * 256 + ch * 8), (LAS unsigned*)(kb + (w * 64 + 512 * i) * 16), 16, 0, 0); }
            { const int blk = p >> 8, row = t0 + kt * 64 + ((p >> 2) & 63), c4 = p & 3;
              __builtin_amdgcn_global_load_lds((const unsigned*)(MV + (size_t)row * 1024 + head * 256 + blk * 32 + c4 * 8), (LAS unsigned*)(vb + (w * 64 + 512 * i) * 16), 16, 0, 0); } }
    };
    const int NT = 2 * rhf + 2;
    g_load(0, 0);
    const int tl = 128 * rhf + 32 * rg + r32;
    bf16x8 qr[16];
    { const bf16_t* qp = MQ + (size_t)(t0 + tl) * 1024 + head * 256 + hi * 8;
#pragma unroll
      for (int d0 = 0; d0 < 16; ++d0) qr[d0] = *(const bf16x8*)(qp + d0 * 16); }
    __syncthreads();
    const float Mt = CMt[tl], bt = Bt[tl];
    f32x16 oT[4];
#pragma unroll
    for (int b = 0; b < 4; ++b)
#pragma unroll
        for (int r = 0; r < 16; ++r) oT[b][r] = 0.f;
    float den_inter = 0.f;
    if (cidx > 0) {
        const float winter = __expf(m_in - Mt);
        const bf16_t* cp = CST + (size_t)((cidx - 1) * 4 + head) * 65536 + (size_t)(dvh * 128 + r32) * 256 + hi * 8;
#pragma unroll
        for (int b = 0; b < 4; ++b)
#pragma unroll
            for (int d0 = 0; d0 < 16; ++d0) { const bf16x8 cf = *(const bf16x8*)(cp + (size_t)b * 32 * 256 + d0 * 16); oT[b] = __builtin_amdgcn_mfma_f32_32x32x16_bf16(cf, qr[d0], oT[b], 0, 0, 0); }
#pragma unroll
        for (int b = 0; b < 4; ++b)
#pragma unroll
            for (int r = 0; r < 16; ++r) oT[b][r] *= winter;
        float qn = 0.f;
#pragma unroll
        for (int d0 = 0; d0 < 16; ++d0) { const u32x4 qq = __builtin_bit_cast(u32x4, qr[d0]); const LAS float* np = Nt + d0 * 16 + hi * 8;
            qn += bflo(qq.x) * np[0] + bfhi(qq.x) * np[1] + bflo(qq.y) * np[2] + bfhi(qq.y) * np[3] + bflo(qq.z) * np[4] + bfhi(qq.z) * np[5] + bflo(qq.w) * np[6] + bfhi(qq.w) * np[7]; }
        den_inter = winter * swap32_sum(qn);
    }
    float dsum = 0.f;
    for (int kt = 0; kt < NT; ++kt) {
        const int buf = kt & 1;
        if (kt + 1 < NT) g_load(kt + 1, buf ^ 1);
        if (64 * kt <= 128 * rhf + 32 * rg + 31) {
            const LAS unsigned char* Kb = lds + buf * BUF; const LAS unsigned char* Vb = Kb + KB;
            f32x16 p0, p1;
#pragma unroll
            for (int r = 0; r < 16; ++r) { p0[r] = 0.f; p1[r] = 0.f; }
#pragma unroll
            for (int d0 = 0; d0 < 16; ++d0) {
                const bf16x8 k0 = *(const LAS bf16x8*)(Kb + (2 * d0 + hi) * 1024 + r32 * 16);
                const bf16x8 k1 = *(const LAS bf16x8*)(Kb + (2 * d0 + hi) * 1024 + r32 * 16 + 512);
                p0 = __builtin_amdgcn_mfma_f32_32x32x16_bf16(k0, qr[d0], p0, 0, 0, 0);
                p1 = __builtin_amdgcn_mfma_f32_32x32x16_bf16(k1, qr[d0], p1, 0, 0, 0);
            }
#pragma unroll
            for (int q4 = 0; q4 < 4; ++q4) {
                const int s0 = 64 * kt + 8 * q4 + 4 * hi;
                const f32x4 g0 = *(const LAS f32x4*)(Gt + s0), g1 = *(const LAS f32x4*)(Gt + s0 + 32);
#pragma unroll
                for (int e = 0; e < 4; ++e) {
                    const float w0 = (s0 + e <= tl) ? __expf(g0[e] - Mt) : 0.f, w1 = (s0 + 32 + e <= tl) ? __expf(g1[e] - Mt) : 0.f;
                    p0[4 * q4 + e] *= w0; p1[4 * q4 + e] *= w1; dsum += p0[4 * q4 + e] + p1[4 * q4 + e];
                }
            }
            bf16x8 pw[4]; pw[0] = pack8(p0, 0); pw[1] = pack8(p0, 8); pw[2] = pack8(p1, 0); pw[3] = pack8(p1, 8);
#pragma unroll
            for (int b = 0; b < 4; ++b)
#pragma unroll
                for (int ks = 0; ks < 4; ++ks) { const bf16x8 vf = tr_frag(Vb + (dvh * 4 + b) * 4096 + ks * 1024, lane); oT[b] = __builtin_amdgcn_mfma_f32_32x32x16_bf16(vf, pw[ks], oT[b], 0, 0, 0); }
        }
        __syncthreads();
    }
    const float den = swap32_sum(dsum) + den_inter;
    const float inv = 1.f / fmaxf(fabsf(den), __expf(-(bt + Mt)));
    float s1 = 0.f, s2 = 0.f;
#pragma unroll
    for (int b = 0; b < 4; ++b)
#pragma unroll
        for (int r = 0; r < 16; ++r) { oT[b][r] *= inv; s1 += oT[b][r]; s2 += oT[b][r] * oT[b][r]; }
    s1 = swap32_sum(s1); s2 = swap32_sum(s2);
    LAS float* LN = (LAS float*)(lds + ML_LN);
    if (hi == 0) { LN[(dvh * 128 + rg * 32 + r32) * 2] = s1; LN[(dvh * 128 + rg * 32 + r32) * 2 + 1] = s2; }
    __syncthreads();
    { const int ot = ((dvh ^ 1) * 128 + rg * 32 + r32) * 2; s1 += LN[ot]; s2 += LN[ot + 1]; }
    const float mu = s1 * (1.f / 256.f), rstd = rsqrtf(fmaxf(s2 * (1.f / 256.f) - mu * mu, 0.f) + EPS);
    const size_t grow = (size_t)(t0 + tl) * 1024 + head * 256;
#pragma unroll
    for (int b = 0; b < 4; ++b)
#pragma unroll
        for (int g = 0; g < 4; ++g) {
            const int dv = dvh * 128 + b * 32 + 8 * g + 4 * hi;
            const f32x4 gh = *(const f32x4*)(ghn + head * 256 + dv), sk = *(const f32x4*)(skip + head * 256 + dv);
            const u32x2 xx = *(const u32x2*)(XC + grow + dv), zz = *(const u32x2*)(Z + grow + dv);
            const float x0 = bflo(xx.x), x1 = bfhi(xx.x), x2 = bflo(xx.y), x3 = bfhi(xx.y);
            const float v0 = ((oT[b][4 * g] - mu) * rstd * gh[0] + sk[0] * x0) * silu_f(bflo(zz.x));
            const float v1 = ((oT[b][4 * g + 1] - mu) * rstd * gh[1] + sk[1] * x1) * silu_f(bfhi(zz.x));
            const float v2 = ((oT[b][4 * g + 2] - mu) * rstd * gh[2] + sk[2] * x2) * silu_f(bflo(zz.y));
            const float v3 = ((oT[b][4 * g + 3] - mu) * rstd * gh[3] + sk[3] * x3) * silu_f(bfhi(zz.y));
            u32x2 o; o.x = pk2(v0, v1); o.y = pk2(v2, v3);
            *(u32x2*)(OUTM + grow + dv) = o;
        }
    __syncthreads();
}

DEV void norm_phase(const Ctx& c, const bf16_t* mix, const float* ssq16, const float* gpost, float* h, bf16_t* hb, float* rsx) {
    f32x4 g[4];
#pragma unroll
    for (int j = 0; j < 4; ++j) g[j] = *(const f32x4*)(gpost + 4 * c.lane + 256 * j);
    for (int row = c.gw; row < S; row += c.NGW) {
        const float* sp = ssq16 + (size_t)row * 16;
        float ssq = 0.f;
#pragma unroll
        for (int i = 0; i < 16; ++i) ssq += sp[i];
        const float rp = rsqrtf(ssq * (1.f / 1024.f) + EPS);
        float* hr = h + (size_t)row * D; const bf16_t* mr = mix + (size_t)row * D; bf16_t* br = hb + (size_t)row * D;
        f32x4 v[4]; float s2 = 0.f;
#pragma unroll
        for (int j = 0; j < 4; ++j) {
            const u32x2 mm = *(const u32x2*)(mr + 4 * c.lane + 256 * j);
            const f32x4 hv = *(const f32x4*)(hr + 4 * c.lane + 256 * j);
            f32x4 mv = {bflo(mm.x), bfhi(mm.x), bflo(mm.y), bfhi(mm.y)};
            v[j] = hv + mv * g[j] * rp;
            s2 += sq4(v[j]);
        }
        s2 = wave_sum(s2);
#pragma unroll
        for (int j = 0; j < 4; ++j) {
            *(f32x4*)(hr + 4 * c.lane + 256 * j) = v[j];
            u32x2 o; o.x = pk2(v[j][0], v[j][1]); o.y = pk2(v[j][2], v[j][3]);
            *(u32x2*)(br + 4 * c.lane + 256 * j) = o;
        }
        if (c.lane == 0) rsx[row] = rsqrtf(s2 * (1.f / 1024.f) + EPS);
    }
}


#define PROBE 0
#if PROBE
DEV void probe_err(unsigned* ctl, float err) { if (!(err == err)) err = 1e30f; atomicMax(ctl + 512, __float_as_uint(fabsf(err))); }
DEV void probe_rms(unsigned* ctl, float got, float ref) { float d = got - ref; if (!(d == d)) d = 1e15f; atomicAdd((float*)ctl + 513, d * d); atomicAdd((float*)ctl + 514, ref * ref); }
__global__ void probe_report(const unsigned* ctl, const float* x, float* out) {
    float e = __uint_as_float(ctl[512]);
    int k = e < 0.02f ? 0 : e < 0.05f ? 1 : e < 0.1f ? 2 : e < 0.3f ? 3 : e < 1.f ? 4 : e < 1e29f ? 5 : 6;
    const float den = ((const float*)ctl)[514];
    if (den > 0.f) { e = sqrtf(((const float*)ctl)[513] / den); k = e < 0.003f ? 0 : e < 0.01f ? 1 : e < 0.03f ? 2 : e < 0.1f ? 3 : e < 0.3f ? 4 : e < 1e6f ? 5 : 6; }
    const float f = 1.f + (float)k;
    for (size_t i = blockIdx.x * (size_t)blockDim.x + threadIdx.x; i < (size_t)S * D; i += (size_t)gridDim.x * blockDim.x) out[i] = x[i] * f;
}
__global__ void probe_e1(Args a, int layer) {
    __shared__ float hn[1024]; __shared__ float red[8]; __shared__ float ref[1968];
    const int row = (blockIdx.x * 131 + 7) % S, tid = threadIdx.x, j = layer >> 1;
    const float* x = a.in[0] + (size_t)row * D; const float* g = a.in[3] + layer * 1024; const float* W = a.in[10] + (size_t)j * 1024 * 1968;
    float s2 = 0.f; for (int k = tid; k < 1024; k += 512) s2 += x[k] * x[k];
    s2 = wave_sum(s2); if ((tid & 63) == 0) red[tid >> 6] = s2; __syncthreads();
    float tot = 0.f; for (int i = 0; i < 8; ++i) tot += red[i];
    const float rs = rsqrtf(tot / 1024.f + EPS);
    for (int k = tid; k < 1024; k += 512) hn[k] = x[k] * rs * g[k];
    __syncthreads();
    for (int n = tid; n < 1968; n += 512) { float acc = 0.f; for (int k = 0; k < 1024; ++k) acc += hn[k] * W[(size_t)k * 1968 + n]; ref[n] = acc; }
    __syncthreads();
    const int pos = ((const int*)a.in[2])[row];
    if (tid < 16) { const float inv = powf(10000.f, -(float)tid / 16.f); const float ang = (float)pos * inv; const float c = cosf(ang), sn = sinf(ang);
        const float x1 = ref[384 + tid], x2 = ref[384 + 16 + tid]; ref[384 + tid] = x1 * c - x2 * sn; ref[384 + 16 + tid] = x2 * c + x1 * sn; }
    __syncthreads();
    const bf16_t* proj = (const bf16_t*)(a.ws + WS_R + R_PROJ) + (size_t)row * 2048;
    unsigned* ctl = (unsigned*)(a.ws + WS_CTL);
    CmE1 cm;
    for (int n = tid; n < 1968; n += 512) probe_err(ctl, bf1(proj[cm(n)]) - ref[n]);
    for (int n = 432 + tid; n < 512; n += 512) probe_err(ctl, bf1(proj[n]));
}

__global__ void probe_e2(Args a, int layer) {
    __shared__ float cq[256]; __shared__ float ckv[128]; __shared__ float red[8]; __shared__ float ref[1024];
    const int row = (blockIdx.x * 131 + 7) % S, tid = threadIdx.x, j = layer >> 1;
    const bf16_t* proj = (const bf16_t*)(a.ws + WS_R + R_PROJ) + (size_t)row * 2048;
    unsigned* ctl = (unsigned*)(a.ws + WS_CTL);
    float s2 = 0.f; if (tid < 256) { cq[tid] = bf1(proj[tid]); s2 = cq[tid] * cq[tid]; }
    s2 = wave_sum(s2); if ((tid & 63) == 0) red[tid >> 6] = s2; __syncthreads();
    float tot = 0.f; for (int i = 0; i < 8; ++i) tot += red[i];
    const float rq = rsqrtf(tot / 256.f + EPS);
    __syncthreads();
    s2 = 0.f; if (tid < 128) { ckv[tid] = bf1(proj[256 + tid]); s2 = ckv[tid] * ckv[tid]; }
    s2 = wave_sum(s2); if ((tid & 63) == 0) red[tid >> 6] = s2; __syncthreads();
    tot = 0.f; for (int i = 0; i < 8; ++i) tot += red[i];
    const float rkv = rsqrtf(tot / 128.f + EPS);
    if (tid < 256) cq[tid] *= rq * a.in[11][j * 256 + tid];
    if (tid < 128) ckv[tid] *= rkv * a.in[13][j * 128 + tid];
    __syncthreads();
    const float* Wq = a.in[12] + (size_t)j * 256 * 768; const float* Wkv = a.in[14] + (size_t)j * 128 * 1024;
    const float qs = 0.10206207261596575f * LOG2E;
    for (int n = tid; n < 768; n += 512) { float acc = 0.f; for (int k = 0; k < 256; ++k) acc += cq[k] * Wq[(size_t)k * 768 + n]; ref[n] = acc * qs; }
    __syncthreads();
    const int pos = ((const int*)a.in[2])[row];
    if (tid < 128) { const int hh = tid >> 4, i = tid & 15; const float inv = powf(10000.f, -(float)i / 16.f); const float ang = (float)pos * inv; const float cs = cosf(ang), sn = sinf(ang);
        const float x1 = ref[hh * 96 + 64 + i], x2 = ref[hh * 96 + 80 + i]; ref[hh * 96 + 64 + i] = x1 * cs - x2 * sn; ref[hh * 96 + 80 + i] = x2 * cs + x1 * sn; }
    __syncthreads();
    const bf16_t* Q = (const bf16_t*)(a.ws + WS_R + R_Q) + (size_t)row * 768;
    CmQ cmq; for (int n = tid; n < 768; n += 512) probe_err(ctl, (bf1(Q[cmq(n)]) - ref[n]) * (1.f / 0.147f));
    __syncthreads();
    for (int n = tid; n < 1024; n += 512) { float acc = 0.f; for (int k = 0; k < 128; ++k) acc += ckv[k] * Wkv[(size_t)k * 1024 + n]; ref[n] = acc; }
    __syncthreads();
    const bf16_t* KN = (const bf16_t*)(a.ws + WS_R + R_KN) + (size_t)row * 512; const bf16_t* V = (const bf16_t*)(a.ws + WS_R + R_V) + (size_t)row * 512;
    for (int n = tid; n < 1024; n += 512) { const int hh = n >> 7, r = n & 127; const float got = r < 64 ? bf1(KN[hh * 64 + r]) : bf1(V[hh * 64 + r - 64]); probe_err(ctl, got - ref[n]); }
}
__global__ void __launch_bounds__(256) probe_mla(Args a) {
    __shared__ float q[96]; __shared__ float red[4]; __shared__ float ored[4][64]; __shared__ float lred[4];
    const int si = blockIdx.x >> 3, head = blockIdx.x & 7, tid = threadIdx.x;
    int row = (si * 529 + (si % 3) * 63) % S;
    switch (si) { case 0: row = 0; break; case 1: row = 1; break; case 2: row = 63; break; case 3: row = 64; break; case 4: row = 255; break; case 5: row = 256; break;
                  case 6: row = 257; break; case 7: row = 4095; break; case 8: row = 4096; break; case 9: row = 8191; break; case 10: row = 16383; break; case 11: row = 16128; break; default: break; }
    const bf16_t* Q = (const bf16_t*)(a.ws + WS_R + R_Q); const bf16_t* KN = (const bf16_t*)(a.ws + WS_R + R_KN); const bf16_t* V = (const bf16_t*)(a.ws + WS_R + R_V);
    const bf16_t* PJ = (const bf16_t*)(a.ws + WS_R + R_PROJ); const bf16_t* CAT = (const bf16_t*)(a.ws + WS_R + R_CAT);
    unsigned* ctl = (unsigned*)(a.ws + WS_CTL);
    if (tid < 96) q[tid] = bf1(Q[(size_t)row * 768 + head * 96 + tid]);
    __syncthreads();
    float mx = -INFINITY;
    for (int k = tid; k <= row; k += 256) { float sc = 0.f; for (int d = 0; d < 64; ++d) sc += q[d] * bf1(KN[(size_t)k * 512 + head * 64 + d]);
        for (int d = 0; d < 32; ++d) sc += q[64 + d] * bf1(PJ[(size_t)k * 2048 + PJ_KPE + d]); mx = fmaxf(mx, sc); }
    for (int o = 1; o < 64; o <<= 1) mx = fmaxf(mx, __shfl_xor(mx, o));
    if ((tid & 63) == 0) red[tid >> 6] = mx; __syncthreads();
    mx = fmaxf(fmaxf(red[0], red[1]), fmaxf(red[2], red[3]));
    float l = 0.f; float o[64];
#pragma unroll
    for (int d = 0; d < 64; ++d) o[d] = 0.f;
    for (int k = tid; k <= row; k += 256) { float sc = 0.f; for (int d = 0; d < 64; ++d) sc += q[d] * bf1(KN[(size_t)k * 512 + head * 64 + d]);
        for (int d = 0; d < 32; ++d) sc += q[64 + d] * bf1(PJ[(size_t)k * 2048 + PJ_KPE + d]);
        const float p = exp2f(sc - mx); l += p;
#pragma unroll
        for (int d = 0; d < 64; ++d) o[d] += p * bf1(V[(size_t)k * 512 + head * 64 + d]); }
    l = wave_sum(l);
#pragma unroll
    for (int d = 0; d < 64; ++d) o[d] = wave_sum(o[d]);
    if ((tid & 63) == 0) { lred[tid >> 6] = l;
#pragma unroll
        for (int d = 0; d < 64; ++d) ored[tid >> 6][d] = o[d]; }
    __syncthreads();
    if (tid < 64) { const float lt = lred[0] + lred[1] + lred[2] + lred[3]; const float ov = (ored[0][tid] + ored[1][tid] + ored[2][tid] + ored[3][tid]) / lt;
        probe_err(ctl, bf1(CAT[(size_t)row * 1024 + head * 64 + tid]) - ov); }
}
__global__ void __launch_bounds__(128) probe_gla(Args a, int layer) {
    __shared__ float qa[64], ka[64], aa[64], red[2];
    const int head = blockIdx.x, dv = threadIdx.x, j = layer >> 1;
    const bf16_t* PJ = (const bf16_t*)(a.ws + WS_R + R_PROJ); const bf16_t* CAT = (const bf16_t*)(a.ws + WS_R + R_CAT);
    const float* wg = a.in[15] + (size_t)j * 16 * 256; const float* bg = a.in[16] + j * 256; const float* gn = a.in[17] + j * 128;
    unsigned* ctl = (unsigned*)(a.ws + WS_CTL);
    float st[64];
#pragma unroll
    for (int d = 0; d < 64; ++d) st[d] = 0.f;
    for (int t = 0; t < S; ++t) {
        const bf16_t* pr = PJ + (size_t)t * 2048;
        if (dv < 64) { float x = bg[head * 64 + dv]; for (int jj = 0; jj < 16; ++jj) x += bf1(pr[PJ_GLR + jj]) * wg[jj * 256 + head * 64 + dv];
            aa[dv] = expf(logsigmoid_ref(x) / 16.f); qa[dv] = bf1(pr[PJ_GQ + head * 64 + dv]) * 0.125f; ka[dv] = bf1(pr[PJ_GK + head * 64 + dv]); }
        __syncthreads();
        const float v = bf1(pr[PJ_GV + head * 128 + dv]);
        float o = 0.f;
#pragma unroll
        for (int d = 0; d < 64; ++d) { st[d] = aa[d] * st[d] + ka[d] * v; o += qa[d] * st[d]; }
        const bool sample = (t % 61 == 0) || t >= S - 64 || t < 130;
        if (sample) {
            float s2 = wave_sum(o * o); if ((dv & 63) == 0) red[dv >> 6] = s2; __syncthreads();
            const float rs = rsqrtf((red[0] + red[1]) / 128.f + EPS);
            const float ref = o * rs * gn[dv] * silu_f(bf1(pr[PJ_R + head * 128 + dv]));
            probe_rms(ctl, bf1(CAT[(size_t)t * 1024 + 512 + head * 128 + dv]), ref);
        }
        __syncthreads();
    }
}
__global__ void __launch_bounds__(256) probe_o23(Args a, int layer) {
    __shared__ float xm[1024], xc[1024], qkv[3072], red[4];
    const int tid = threadIdx.x, j = layer >> 1;
    int t = (blockIdx.x * 257 + 3) % S; if (blockIdx.x < 4) t = blockIdx.x; if (blockIdx.x == 4) t = 255; if (blockIdx.x == 5) t = 256; if (blockIdx.x == 6) t = S - 1;
    const bf16_t* XM = (const bf16_t*)(a.ws + WS_R + R_XM); const bf16_t* XC = (const bf16_t*)(a.ws + WS_R + R_XC);
    const bf16_t* MQ = (const bf16_t*)(a.ws + WS_R + R_MQ); const bf16_t* MK = (const bf16_t*)(a.ws + WS_R + R_MK); const bf16_t* MV = (const bf16_t*)(a.ws + WS_R + R_MV);
    const float* gates = (const float*)(a.ws + WS_GATES);
    unsigned* ctl = (unsigned*)(a.ws + WS_CTL);
    const float* cw = a.in[20] + (size_t)j * 4 * 1024; const float* cb = a.in[21] + j * 1024;
    for (int ch = tid; ch < 1024; ch += 256) {
        float y = cb[ch];
        for (int i = 0; i < 4; ++i) { const int tt = t - 3 + i; if (tt >= 0) y += cw[i * 1024 + ch] * bf1(XM[(size_t)tt * 1024 + ch]); }
        const float v = y / (1.f + expf(-y));
        xm[ch] = bf1(XM[(size_t)t * 1024 + ch]); xc[ch] = v;
        probe_rms(ctl, bf1(XC[(size_t)t * 1024 + ch]), v);
    }
    __syncthreads();
    for (int o = tid; o < 3072; o += 256) {
        const int which = o >> 10, hh = (o >> 8) & 3, e = o & 255;
        const float* W = a.in[22 + which] + ((size_t)j * 4 + hh) * 65536;
        const float* src = (which == 2 ? xm : xc) + hh * 256;
        float acc = 0.f; for (int d = 0; d < 256; ++d) acc += src[d] * W[d * 256 + e];
        qkv[hh * 768 + which * 256 + e] = acc;
        const bf16_t* M = which == 0 ? MQ : which == 1 ? MK : MV;
        probe_rms(ctl, bf1(M[(size_t)t * 1024 + hh * 256 + e]), which == 0 ? acc * 0.0625f : acc);
    }
    __syncthreads();
    for (int g = 0; g < 8; ++g) {
        float acc = 0.f; for (int i = tid; i < 3072; i += 256) acc += qkv[i] * a.in[25][(size_t)j * 3072 * 8 + (size_t)i * 8 + g];
        acc = wave_sum(acc); if ((tid & 63) == 0) red[tid >> 6] = acc; __syncthreads();
        if (tid == 0) { const float ref = red[0] + red[1] + red[2] + red[3] + a.in[26][j * 8 + g]; probe_rms(ctl, gates[(size_t)t * 8 + g] * 4.f, ref * 4.f); probe_err(ctl, (gates[(size_t)t * 8 + g] - ref) * 0.2f); }
        __syncthreads();
    }
}
__global__ void __launch_bounds__(512) probe_mlstm(Args a, int layer) {
    __shared__ float q[256], k[256], numred[2][256], red[16], red2[4];
    const int head = blockIdx.x, tid = threadIdx.x, dv = tid & 255, part = tid >> 8, j = layer >> 1;
    const bf16_t* MQ = (const bf16_t*)(a.ws + WS_R + R_MQ); const bf16_t* MK = (const bf16_t*)(a.ws + WS_R + R_MK); const bf16_t* MV = (const bf16_t*)(a.ws + WS_R + R_MV);
    const bf16_t* XC = (const bf16_t*)(a.ws + WS_R + R_XC); const bf16_t* Z = (const bf16_t*)(a.ws + WS_R + R_Z); const bf16_t* OUTM = (const bf16_t*)(a.ws + WS_HB);
    const float* gates = (const float*)(a.ws + WS_GATES); unsigned* ctl = (unsigned*)(a.ws + WS_CTL);
    float C[128];
#pragma unroll
    for (int i = 0; i < 128; ++i) C[i] = 0.f;
    float nn = 0.f, m = 0.f;
    for (int t = 0; t < S; ++t) {
        if (tid < 256) { q[tid] = bf1(MQ[(size_t)t * 1024 + head * 256 + tid]); k[tid] = bf1(MK[(size_t)t * 1024 + head * 256 + tid]); }
        __syncthreads();
        const float v = bf1(MV[(size_t)t * 1024 + head * 256 + dv]);
        const float ii = gates[(size_t)t * 8 + head], lf = logsigmoid_ref(gates[(size_t)t * 8 + 4 + head]);
        const float mnew = fmaxf(lf + m, ii), fd = expf(lf + m - mnew), idd = expf(ii - mnew); m = mnew;
        float num = 0.f;
#pragma unroll
        for (int i = 0; i < 128; ++i) { const int dk = part * 128 + i; C[i] = fd * C[i] + idd * k[dk] * v; num += q[dk] * C[i]; }
        numred[part][dv] = num;
        float dp = 0.f;
        if (tid < 256) { nn = fd * nn + idd * k[tid]; dp = q[tid] * nn; }
        dp = wave_sum(dp); if ((tid & 63) == 0) red[tid >> 6] = dp;
        __syncthreads();
        const bool sample = (t % 53 == 0) || t < 300 || t >= S - 300;
        if (sample) {
            const float den = red[0] + red[1] + red[2] + red[3] + red[4] + red[5] + red[6] + red[7];
            float hv = 0.f, s1 = 0.f, s2 = 0.f;
            if (tid < 256) { hv = (numred[0][dv] + numred[1][dv]) / fmaxf(fabsf(den), expf(-m)); s1 = hv; }
            s1 = wave_sum(s1); if ((tid & 63) == 0 && tid < 256) red2[tid >> 6] = s1; __syncthreads();
            const float mu = (red2[0] + red2[1] + red2[2] + red2[3]) / 256.f; __syncthreads();
            if (tid < 256) s2 = (hv - mu) * (hv - mu);
            s2 = wave_sum(s2); if ((tid & 63) == 0 && tid < 256) red2[tid >> 6] = s2; __syncthreads();
            const float rstd = rsqrtf((red2[0] + red2[1] + red2[2] + red2[3]) / 256.f + EPS);
            if (tid < 256) { const size_t gi = (size_t)t * 1024 + head * 256 + dv;
                const float ref = ((hv - mu) * rstd * a.in[27][j * 1024 + head * 256 + dv] + a.in[28][j * 1024 + head * 256 + dv] * bf1(XC[gi])) * silu_f(bf1(Z[gi]));
                probe_rms(ctl, bf1(OUTM[gi]), ref); }
        }
        __syncthreads();
    }
}
#endif

__global__ void __launch_bounds__(NTHREADS, 2) fwd(Args args) {
    extern __shared__ __attribute__((aligned(16))) unsigned char lds_raw[];
    typedef const Args __attribute__((address_space(4)))* ArgsP;
    ArgsP ap0 = (ArgsP)__builtin_amdgcn_kernarg_segment_ptr();
#define ARGS() ({ ArgsP _q = ap0; asm volatile("" : "+s"(_q)); _q; })
    const int lo = ap0->ph_lo, hi = ap0->ph_hi;
    const int wave0 = __builtin_amdgcn_readfirstlane((int)threadIdx.x >> 6);
#define IN(k) (lo <= (k) && (k) < hi)
#define PHASE_CTX() \
    Ctx c; { int w_ = wave0; asm volatile("" : "+s"(w_)); unsigned z_ = 0u; asm volatile("" : "+s"(z_)); int l_ = (int)__builtin_amdgcn_mbcnt_hi(~0u, __builtin_amdgcn_mbcnt_lo(~0u, z_)); \
      c.lds = (LAS unsigned char*)lds_raw; c.tid = w_ * 64 + l_; c.lane = l_; c.wave = w_; \
      c.G = gridDim.x; const int bx_ = blockIdx.x; c.vcu = (c.G % 8 == 0) ? (bx_ % 8) * (c.G / 8) + bx_ / 8 : bx_; c.gw = c.vcu * NWAVES + c.wave; c.NGW = c.G * NWAVES; } \
    ArgsP ap = ARGS(); unsigned char* ws = ap->ws; float* h = ap->out; \
    float* cosT = (float*)(ws + WS_COS); float* sinT = (float*)(ws + WS_SIN); \
    float* rsx = (float*)(ws + WS_RSX); float* ssq16 = (float*)(ws + WS_SSQ16); \
    float* ssqq = (float*)(ws + WS_SSQQ); float* ssqkv = (float*)(ws + WS_SSQKV); \
    bf16_t* HB = (bf16_t*)(ws + WS_HB); bf16_t* MIX = (bf16_t*)(ws + WS_MIX); \
    unsigned char* R = ws + WS_R; unsigned char* WB = ws + WS_WB; \
    (void)h; (void)cosT; (void)sinT; (void)rsx; (void)ssq16; (void)ssqq; (void)ssqkv; (void)HB; (void)MIX; (void)R; (void)WB;

    if (IN(0)) {
        PHASE_CTX();
        const float* x = ap->in[0]; const int* pos = (const int*)ap->in[2];
        for (int i = c.gw * 64 + c.lane; i < S * 16; i += c.NGW * 64) {
            const int t = i >> 4, f = i & 15;
            const double inv = pow(10000.0, -(double)f / 16.0);
            const double ang = (double)pos[t] * inv;
            cosT[i] = (float)cos(ang); sinT[i] = (float)sin(ang);
        }
        for (int row = c.gw; row < S; row += c.NGW) {
            const float* xr = x + (size_t)row * D; float* hr = h + (size_t)row * D; bf16_t* br = HB + (size_t)row * D;
            float s2 = 0.f;
#pragma unroll
            for (int j = 0; j < 4; ++j) {
                const f32x4 v = *(const f32x4*)(xr + 4 * c.lane + 256 * j);
                s2 += sq4(v);
                *(f32x4*)(hr + 4 * c.lane + 256 * j) = v;
                u32x2 o; o.x = pk2(v[0], v[1]); o.y = pk2(v[2], v[3]);
                *(u32x2*)(br + 4 * c.lane + 256 * j) = o;
            }
            s2 = wave_sum(s2);
            if (c.lane == 0) rsx[row] = rsqrtf(s2 * (1.f / 1024.f) + EPS);
        }
        for (int rr = c.gw; rr < NLAYER * NMEM; rr += c.NGW) {
            const int l = rr >> 8, row = rr & 255;
            const float* mr = ap->in[1] + (size_t)row * D; const float* g = ap->in[7] + l * 1024; bf16_t* br = (bf16_t*)(ws + WS_MEMN) + (size_t)rr * D;
            f32x4 v[4]; float s2 = 0.f;
#pragma unroll
            for (int j = 0; j < 4; ++j) { v[j] = *(const f32x4*)(mr + 4 * c.lane + 256 * j); s2 += sq4(v[j]); }
            s2 = wave_sum(s2);
            const float rs = rsqrtf(s2 * (1.f / 1024.f) + EPS);
#pragma unroll
            for (int j = 0; j < 4; ++j) { const f32x4 gg = *(const f32x4*)(g + 4 * c.lane + 256 * j); const f32x4 o4 = v[j] * gg * rs;
                u32x2 o; o.x = pk2(o4[0], o4[1]); o.y = pk2(o4[2], o4[3]); *(u32x2*)(br + 4 * c.lane + 256 * j) = o; }
        }
        for (int l = 0; l < NLAYER; ++l) {
            prep_job(c, ap->in[31] + (size_t)l * 1024 * 1024, 1024, 1024, 1024, nullptr, 1.f, (bf16_t*)(R + R_XKT) + (size_t)(l * 2 + 0) * 1024 * 1024, 1024, CmId{0});
            prep_job(c, ap->in[32] + (size_t)l * 1024 * 1024, 1024, 1024, 1024, nullptr, 1.f, (bf16_t*)(R + R_XKT) + (size_t)(l * 2 + 1) * 1024 * 1024, 1024, CmId{0});
        }
    }
    if (IN(1)) {
        PHASE_CTX();
        pg8::StaticOrder so; so.init(1, 32, c.G, (int)blockIdx.x);
        ProbKV P{(const bf16_t*)(ws + WS_MEMN), (const bf16_t*)(R + R_XKT), 1024, 1024, 16, (bf16_t*)(ws + WS_KX), (bf16_t*)(ws + WS_VX)};
        pg8::gemm_phase(c.lds, c.tid, so, P);
    }
    for (int l = 0; l < NLAYER; ++l) {
        const int pb = 2 + l * 16;
        const bool even = (l & 1) == 0;
        if (IN(pb + 0)) {
            PHASE_CTX(); int L = l; asm volatile("" : "+s"(L)); const int J = L >> 1; (void)J;
            if (even) {
                prep_job(c, ap->in[10] + (size_t)J * 1024 * 1968, 1968, 1024, 1968, ap->in[3] + L * 1024, 1.f, (bf16_t*)(WB + WB_WIN), 1024, CmE1());
                zero_block(c, (bf16_t*)(WB + WB_WIN) + (size_t)432 * 1024, 80, 1024, 1024);
                prep_job(c, ap->in[12] + (size_t)J * 256 * 768, 768, 256, 768, ap->in[11] + J * 256, 0.10206207261596575f * LOG2E, (bf16_t*)(WB + WB_WUQ), 256, CmQ());
                prep_job(c, ap->in[14] + (size_t)J * 128 * 1024, 1024, 128, 1024, ap->in[13] + J * 128, 1.f, (bf16_t*)(WB + WB_WUKV), 256, CmKV());
                zero_block(c, (bf16_t*)(WB + WB_WUKV) + 128, 1024, 128, 256);
                prep_job(c, ap->in[18] + (size_t)J * 1024 * 1024, 1024, 1024, 1024, nullptr, 1.f, (bf16_t*)(WB + WB_WOUT), 1024, CmId{0});
            }
            if (!even) {
                prep_job(c, ap->in[19] + (size_t)J * 1024 * 2048, 2048, 1024, 2048, ap->in[3] + L * 1024, 1.f, (bf16_t*)(WB + WB_WIN), 1024, CmId{0});
                for (int hh = 0; hh < 4; ++hh) {
                    prep_job(c, ap->in[22] + ((size_t)J * 4 + hh) * 65536, 256, 256, 256, nullptr, 0.0625f, (bf16_t*)(WB + WB_W3) + (size_t)(0 + hh) * 65536, 256, CmId{0});
                    prep_job(c, ap->in[23] + ((size_t)J * 4 + hh) * 65536, 256, 256, 256, nullptr, 1.f, (bf16_t*)(WB + WB_W3) + (size_t)(4 + hh) * 65536, 256, CmId{0});
                    prep_job(c, ap->in[24] + ((size_t)J * 4 + hh) * 65536, 256, 256, 256, nullptr, 1.f, (bf16_t*)(WB + WB_W3) + (size_t)(8 + hh) * 65536, 256, CmId{0});
                }
                prep_job(c, ap->in[29] + (size_t)J * 1024 * 1024, 1024, 1024, 1024, nullptr, 1.f, (bf16_t*)(WB + WB_WOUT), 1024, CmId{0});
                gatefold_job(c, ap->in[22] + (size_t)J * 4 * 65536, ap->in[23] + (size_t)J * 4 * 65536, ap->in[24] + (size_t)J * 4 * 65536, ap->in[25] + (size_t)J * 3072 * 8, (float*)(ws + WS_G12));
            }
            prep_job(c, ap->in[30] + (size_t)L * 1024 * 1024, 1024, 1024, 1024, ap->in[5] + L * 1024, 0.0625f * LOG2E, (bf16_t*)(WB + WB_XQ), 1024, CmId{0});
            prep_job(c, ap->in[33] + (size_t)L * 1024 * 1024, 1024, 1024, 1024, nullptr, 1.f, (bf16_t*)(WB + WB_XO), 1024, CmId{0});
            prep_job(c, ap->in[34] + (size_t)L * 1024 * 4096, 4096, 1024, 4096, ap->in[8] + L * 1024, 1.f, (bf16_t*)(WB + WB_W1), 1024, CmId{0});
            prep_job(c, ap->in[35] + (size_t)L * 4096 * 1024, 1024, 4096, 1024, nullptr, 1.f, (bf16_t*)(WB + WB_W2), 4096, CmId{0});
        }
        if (even) {
            if (IN(pb + 1)) {
                PHASE_CTX(); int L = l; asm volatile("" : "+s"(L)); const int J = L >> 1; (void)J;
                pg8::StaticOrder so; so.init(S / 256, 8, c.G, (int)blockIdx.x);
                ProbE1 P{HB, (const bf16_t*)(WB + WB_WIN), 1024, 1024, 16, (bf16_t*)(R + R_PROJ), rsx, ssqq, ssqkv, cosT, sinT};
                pg8::gemm_phase(c.lds, c.tid, so, P);
            }
            if (IN(pb + 2)) {
                PHASE_CTX(); int L = l; asm volatile("" : "+s"(L)); const int J = L >> 1; (void)J;
                pg8::StaticOrder so; so.init(S / 256, 7, c.G, (int)blockIdx.x);
                ProbE2 P{(const bf16_t*)(R + R_PROJ), (const bf16_t*)(WB + WB_WUQ), (const bf16_t*)(WB + WB_WUKV), 2048, 256, 4,
                         (bf16_t*)(R + R_Q), (bf16_t*)(R + R_KN), (bf16_t*)(R + R_V), ssqq, ssqkv, cosT, sinT};
                pg8::gemm_phase(c.lds, c.tid, so, P);
                for (int u = c.vcu; u < 1024; u += c.G)
                    gla_a_unit(c, (const bf16_t*)(R + R_PROJ), ap->in[15] + (size_t)J * 16 * 256, ap->in[16] + J * 256, u >> 2, u & 3, (bf16_t*)(R + R_GST), (float*)(ws + WS_GDEC));
            }
            if (IN(pb + 3)) {
                PHASE_CTX(); int L = l; asm volatile("" : "+s"(L)); const int J = L >> 1; (void)J;
                const bf16_t* Q = (const bf16_t*)(R + R_Q); const bf16_t* KN = (const bf16_t*)(R + R_KN); const bf16_t* V = (const bf16_t*)(R + R_V);
                const bf16_t* PJ = (const bf16_t*)(R + R_PROJ); bf16_t* CAT = (bf16_t*)(R + R_CAT);
                gla_scan(c, (bf16_t*)(R + R_GST), (const float*)(ws + WS_GDEC));
                for (int u = c.vcu; u < 256; u += c.G) {
                    const int head = u >> 5, sidx = u & 31;
                    for (int half = 0; half < 2; ++half) {
                        const int qb = half ? 63 - sidx : sidx;
                        const size_t r0 = (size_t)qb * 256 + c.wave * 32;
                        flash_unit<8, 4, 2, 2, true>(c, Q + r0 * 768 + head * 96, 768, KN + head * 64, 512, PJ + PJ_KPE, 2048, V + head * 64, 512,
                                                     CAT + r0 * 1024 + head * 64, 1024, 4 * (qb + 1), 0, c.wave * 32, 4 * qb);
                    }
                }
            }
            if (IN(pb + 4)) {
                PHASE_CTX(); int L = l; asm volatile("" : "+s"(L)); const int J = L >> 1; (void)J;
                for (int u = c.vcu; u < 1024; u += c.G)
                    gla_c_unit(c, (const bf16_t*)(R + R_PROJ), ap->in[15] + (size_t)J * 16 * 256, ap->in[16] + J * 256, ap->in[17] + J * 128, u >> 2, u & 3, (const bf16_t*)(R + R_GST), (bf16_t*)(R + R_CAT));
            }
            if (IN(pb + 5)) {
                PHASE_CTX(); int L = l; asm volatile("" : "+s"(L)); const int J = L >> 1; (void)J;
                pg8::StaticOrder so; so.init(S / 256, 4, c.G, (int)blockIdx.x);
                ProbPlain P{(const bf16_t*)(R + R_CAT), (const bf16_t*)(WB + WB_WOUT), 1024, 1024, 16, MIX, 1024, nullptr, 1 << 30, nullptr, 0, ssq16, 16};
                pg8::gemm_phase(c.lds, c.tid, so, P);
            }
        }
        if (!even) {
            if (IN(pb + 1)) {
                PHASE_CTX(); int L = l; asm volatile("" : "+s"(L)); const int J = L >> 1; (void)J;
                pg8::StaticOrder so; so.init(S / 256, 8, c.G, (int)blockIdx.x);
                ProbPlain P{HB, (const bf16_t*)(WB + WB_WIN), 1024, 1024, 16, (bf16_t*)(R + R_XM), 1024, (bf16_t*)(R + R_Z), 4, rsx, 0, nullptr, 0};
                pg8::gemm_phase(c.lds, c.tid, so, P);
            }
            if (IN(pb + 2)) {
                PHASE_CTX(); int L = l; asm volatile("" : "+s"(L)); const int J = L >> 1; (void)J;
                conv_phase(c, (const bf16_t*)(R + R_XM), ap->in[20] + (size_t)J * 4 * 1024, ap->in[21] + J * 1024, (const float*)(ws + WS_G12), ap->in[26] + J * 8,
                           (bf16_t*)(R + R_XC), (float*)(ws + WS_GATES));
            }
            if (IN(pb + 3)) {
                PHASE_CTX(); int L = l; asm volatile("" : "+s"(L)); const int J = L >> 1; (void)J;
                pg8::StaticOrder so; so.init(S / 256, 12, c.G, (int)blockIdx.x);
                ProbO3 P{(const bf16_t*)(R + R_XC), (const bf16_t*)(R + R_XM), (const bf16_t*)(WB + WB_W3), 1024, 256, 4, (bf16_t*)(R + R_MQ), (bf16_t*)(R + R_MK), (bf16_t*)(R + R_MV)};
                pg8::gemm_phase(c.lds, c.tid, so, P);
            }
            if (IN(pb + 4)) {
                PHASE_CTX(); int L = l; asm volatile("" : "+s"(L)); const int J = L >> 1; (void)J;
                for (int u = c.vcu; u < 63 * 4; u += c.G)
                    mlstm_a_unit(c, (const float*)(ws + WS_GATES), (const bf16_t*)(R + R_MK), (const bf16_t*)(R + R_MV), u >> 2, u & 3, (bf16_t*)(R + R_XM), (float*)(ws + WS_MST));
            }
            if (IN(pb + 5)) { PHASE_CTX(); int L = l; asm volatile("" : "+s"(L)); const int J = L >> 1; (void)J; mlstm_scan(c, (bf16_t*)(R + R_XM), (float*)(ws + WS_MST)); }
            if (IN(pb + 6)) {
                PHASE_CTX(); int L = l; asm volatile("" : "+s"(L)); const int J = L >> 1; (void)J;
                for (int u = c.vcu; u < 512; u += c.G)
                    mlstm_c_unit(c, (const float*)(ws + WS_GATES), (const bf16_t*)(R + R_MQ), (const bf16_t*)(R + R_MK), (const bf16_t*)(R + R_MV), (const bf16_t*)(R + R_XM), (const float*)(ws + WS_MST),
                                 (const bf16_t*)(R + R_XC), (const bf16_t*)(R + R_Z), ap->in[27] + J * 1024, ap->in[28] + J * 1024, HB, u >> 3, (u >> 1) & 3, u & 1);
            }
            if (IN(pb + 7)) {
                PHASE_CTX(); int L = l; asm volatile("" : "+s"(L)); const int J = L >> 1; (void)J;
                pg8::StaticOrder so; so.init(S / 256, 4, c.G, (int)blockIdx.x);
                ProbPlain P{HB, (const bf16_t*)(WB + WB_WOUT), 1024, 1024, 16, MIX, 1024, nullptr, 1 << 30, nullptr, 0, ssq16, 16};
                pg8::gemm_phase(c.lds, c.tid, so, P);
            }
        }
        if (IN(pb + 8)) { PHASE_CTX(); int L = l; asm volatile("" : "+s"(L)); const int J = L >> 1; (void)J; norm_phase(c, MIX, ssq16, ap->in[4] + L * 1024, h, HB, rsx); }
        if (IN(pb + 9)) {
            PHASE_CTX(); int L = l; asm volatile("" : "+s"(L)); const int J = L >> 1; (void)J;
            pg8::StaticOrder so; so.init(S / 256, 4, c.G, (int)blockIdx.x);
            ProbPlain P{HB, (const bf16_t*)(WB + WB_XQ), 1024, 1024, 16, (bf16_t*)(R + R_XQ), 1024, nullptr, 1 << 30, rsx, 0, nullptr, 0};
            pg8::gemm_phase(c.lds, c.tid, so, P);
        }
        if (IN(pb + 10)) {
            PHASE_CTX(); int L = l; asm volatile("" : "+s"(L)); const int J = L >> 1; (void)J;
            const bf16_t* XQ = (const bf16_t*)(R + R_XQ); bf16_t* XO = (bf16_t*)(R + R_XO);
            const bf16_t* KX = (const bf16_t*)(ws + WS_KX) + (size_t)L * 256 * 1024; const bf16_t* VX = (const bf16_t*)(ws + WS_VX) + (size_t)L * 256 * 1024;
            const int rg = c.wave >> 1, dvh = c.wave & 1;
            for (int u = c.vcu; u < 512; u += c.G) {
                const int pp = u >> 2, head = u & 3;
                const size_t r0 = (size_t)pp * 128 + rg * 32;
                flash_unit<32, 0, 8, 4, false>(c, XQ + r0 * 1024 + head * 256, 1024, KX + head * 256, 1024, KX, 1024, VX + head * 256, 1024,
                                               XO + r0 * 1024 + head * 256 + dvh * 128, 1024, 4, dvh * 4, 0, 0);
            }
        }
        if (IN(pb + 11)) {
            PHASE_CTX(); int L = l; asm volatile("" : "+s"(L)); const int J = L >> 1; (void)J;
            pg8::StaticOrder so; so.init(S / 256, 4, c.G, (int)blockIdx.x);
            ProbPlain P{(const bf16_t*)(R + R_XO), (const bf16_t*)(WB + WB_XO), 1024, 1024, 16, MIX, 1024, nullptr, 1 << 30, nullptr, 0, ssq16, 16};
            pg8::gemm_phase(c.lds, c.tid, so, P);
        }
        if (IN(pb + 12)) { PHASE_CTX(); int L = l; asm volatile("" : "+s"(L)); const int J = L >> 1; (void)J; norm_phase(c, MIX, ssq16, ap->in[6] + L * 1024, h, HB, rsx); }
        if (IN(pb + 13)) {
            PHASE_CTX(); int L = l; asm volatile("" : "+s"(L)); const int J = L >> 1; (void)J;
            pg8::StaticOrder so; so.init(S / 256, 16, c.G, (int)blockIdx.x);
            ProbPlain P{HB, (const bf16_t*)(WB + WB_W1), 1024, 1024, 16, (bf16_t*)(R + R_U), 4096, nullptr, 1 << 30, rsx, 1, nullptr, 0};
            pg8::gemm_phase(c.lds, c.tid, so, P);
        }
        if (IN(pb + 14)) {
            PHASE_CTX(); int L = l; asm volatile("" : "+s"(L)); const int J = L >> 1; (void)J;
            pg8::StaticOrder so; so.init(S / 256, 4, c.G, (int)blockIdx.x);
            ProbPlain P{(const bf16_t*)(R + R_U), (const bf16_t*)(WB + WB_W2), 4096, 4096, 64, MIX, 1024, nullptr, 1 << 30, nullptr, 0, ssq16, 16};
            pg8::gemm_phase(c.lds, c.tid, so, P);
        }
        if (IN(pb + 15)) { PHASE_CTX(); int L = l; asm volatile("" : "+s"(L)); const int J = L >> 1; (void)J; norm_phase(c, MIX, ssq16, ap->in[9] + L * 1024, h, HB, rsx); }
    }
#undef IN
}

extern "C" void kernel_launch(void* const* d_in, const int* in_sizes, int n_in, void* d_out, int out_size, void* d_ws, size_t ws_size, hipStream_t stream) {
    static int grid = 0;
    if (grid == 0) {
        if (n_in != 36 || out_size != S * D || ws_size < WS_END) { fprintf(stderr, "kernel_launch: unexpected shapes (n_in %d, out %d, ws %zu < %zu)\n", n_in, out_size, ws_size, (size_t)WS_END); grid = -1; return; }
        int dev = 0, cus = 0, per_cu = 0;
        hipGetDevice(&dev); hipDeviceGetAttribute(&cus, hipDeviceAttributeMultiprocessorCount, dev);
        if (hipFuncSetAttribute((const void*)fwd, hipFuncAttributeMaxDynamicSharedMemorySize, LDS_BYTES) != hipSuccess) { fprintf(stderr, "kernel_launch: hipFuncSetAttribute failed\n"); grid = -1; return; }
        hipOccupancyMaxActiveBlocksPerMultiprocessor(&per_cu, (const void*)fwd, NTHREADS, LDS_BYTES);
        (void)hipGetLastError();
        grid = cus > 0 ? cus : 256;
    }
    if (grid < 0) return;
    hipMemsetAsync((char*)d_ws + WS_CTL, 0, 1 * MiB, stream);
    Args a{};
    for (int i = 0; i < 36; ++i) a.in[i] = (const float*)d_in[i];
    a.out = (float*)d_out; a.ws = (unsigned char*)d_ws;
    const int PH_END = 2 + 16 * NLAYER;
    for (int p = 0; p < PH_END; ++p) {
        a.ph_lo = p; a.ph_hi = p + 1;
        hipLaunchKernelGGL(fwd, dim3(grid), dim3(NTHREADS), LDS_BYTES, stream, a);
    }
#if PROBE
    hipLaunchKernelGGL(probe_mlstm, dim3(4), dim3(512), 0, stream, a, 1);
    hipLaunchKernelGGL(probe_report, dim3(1024), dim3(256), 0, stream, (const unsigned*)d_ws, (const float*)d_in[0], (float*)d_out);
#endif
}
```

```cpp
#include <hip/hip_runtime.h>
#include <cstdio>
#include <cstdint>

#define LAS __attribute__((address_space(3)))
#define GAS __attribute__((address_space(1)))
#define DEV __device__ __forceinline__
typedef unsigned short bf16_t;
typedef short bf16x8 __attribute__((ext_vector_type(8)));
typedef short s16x4 __attribute__((ext_vector_type(4)));
typedef float f32x4 __attribute__((ext_vector_type(4)));
typedef float f32x16 __attribute__((ext_vector_type(16)));
typedef float f32x2 __attribute__((ext_vector_type(2)));
typedef unsigned u32x4 __attribute__((ext_vector_type(4)));
typedef unsigned u32x2 __attribute__((ext_vector_type(2)));
typedef __bf16 bf16x2_t __attribute__((ext_vector_type(2)));
typedef short v4i16_t __attribute__((ext_vector_type(4)));

constexpr int S = 16384, D = 1024, NLAYER = 4, NMEM = 256, DFF = 4096;
constexpr float EPS = 1e-6f;
constexpr float LOG2E = 1.4426950408889634f;
constexpr int NTHREADS = 512, NWAVES = 8;

constexpr size_t MiB = 1u << 20, KiB = 1024;
constexpr size_t WS_CTL = 0;
constexpr size_t WS_COS = 1 * MiB;
constexpr size_t WS_SIN = 2 * MiB;
constexpr size_t WS_RSX = 3 * MiB;
constexpr size_t WS_SSQ16 = 4 * MiB;
constexpr size_t WS_SSQQ = 5 * MiB;
constexpr size_t WS_SSQKV = 5 * MiB + 256 * KiB;
constexpr size_t WS_GATES = 5 * MiB + 512 * KiB;
constexpr size_t WS_G12 = 6 * MiB;
constexpr size_t WS_GDEC = 6 * MiB + 128 * KiB;
constexpr size_t WS_MST = 6 * MiB + 512 * KiB;
constexpr size_t WS_KX = 8 * MiB;
constexpr size_t WS_VX = 10 * MiB;
constexpr size_t WS_MEMN = 12 * MiB;
constexpr size_t WS_WB = 16 * MiB;
constexpr size_t WS_HB = 44 * MiB;
constexpr size_t WS_MIX = 76 * MiB;
constexpr size_t WS_R = 108 * MiB;
constexpr size_t WS_END = 300 * MiB;
constexpr size_t WB_WIN = 0;
constexpr size_t WB_WUQ = 4 * MiB;
constexpr size_t WB_WUKV = 4 * MiB + 512 * KiB;
constexpr size_t WB_W3 = 4 * MiB;
constexpr size_t WB_WOUT = 6 * MiB;
constexpr size_t WB_XQ = 8 * MiB;
constexpr size_t WB_XO = 10 * MiB;
constexpr size_t WB_W1 = 12 * MiB;
constexpr size_t WB_W2 = 20 * MiB;
constexpr size_t R_PROJ = 0;
constexpr size_t R_Q = 64 * MiB;
constexpr size_t R_KN = 88 * MiB;
constexpr size_t R_V = 104 * MiB;
constexpr size_t R_CAT = 120 * MiB;
constexpr size_t R_GST = 152 * MiB;
constexpr size_t R_XQ = 0, R_XO = 32 * MiB;
constexpr size_t R_U = 0;
constexpr size_t R_XM = 0, R_Z = 32 * MiB, R_XC = 64 * MiB, R_MQ = 96 * MiB, R_MK = 128 * MiB, R_MV = 160 * MiB;
constexpr size_t R_XKT = 0;

constexpr int PJ_CQ = 0, PJ_CKV = 256, PJ_KPE = 384, PJ_GLR = 416, PJ_GQ = 512, PJ_GK = 768, PJ_GV = 1024, PJ_R = 1536;

constexpr int LDS_BYTES = 160 * 1024;
constexpr int LDS_MISC = 156 * 1024;

DEV unsigned pk2(float lo, float hi) { f32x2 v = {lo, hi}; bf16x2_t b = __builtin_convertvector(v, bf16x2_t); return __builtin_bit_cast(unsigned, b); }
DEV float bflo(unsigned u) { return __uint_as_float(u << 16); }
DEV float bfhi(unsigned u) { return __uint_as_float(u & 0xffff0000u); }
DEV float bf1(bf16_t b) { return __uint_as_float(((unsigned)b) << 16); }
DEV bf16_t f2bf(float f) { return (bf16_t)(pk2(f, 0.f) & 0xffffu); }
DEV float wave_sum(float v) {
#pragma unroll
    for (int o = 1; o < 64; o <<= 1) v += __shfl_xor(v, o);
    return v;
}
DEV int crow(int r, int hi) { return (r & 3) + 8 * (r >> 2) + 4 * hi; }
DEV float swap32_max(float m) { auto rr = __builtin_amdgcn_permlane32_swap(__float_as_uint(m), __float_as_uint(m), false, false); return fmaxf(__uint_as_float(rr[0]), __uint_as_float(rr[1])); }
DEV float swap32_sum(float m) { auto rr = __builtin_amdgcn_permlane32_swap(__float_as_uint(m), __float_as_uint(m), false, false); return __uint_as_float(rr[0]) + __uint_as_float(rr[1]); }
DEV int rope_perm(int l) { return 8 * ((l >> 2) & 3) + 4 * (l >> 4) + (l & 3); }
DEV float silu_f(float x) { return x / (1.f + __expf(-x)); }
DEV float logsigmoid_f(float x) { return fminf(x, 0.f) - __logf(1.f + __expf(-fabsf(x))); }
DEV float logsigmoid_ref(float x) { return fminf(x, 0.f) - log1pf(expf(-fabsf(x))); }
#define LDS_WAIT() asm volatile("s_waitcnt lgkmcnt(0)" ::: "memory")

struct Args {
    const float* in[36];
    float* out;
    unsigned char* ws;
    int ph_lo, ph_hi;
};

struct Ctx {
    LAS unsigned char* lds;
    int tid, lane, wave, G, vcu, gw, NGW;
};


#define XB_TMO      128
#define XB_XCNT(j)  (256  + 64 * (j))
#define XB_XSUB(j)  (1280 + 64 * (j))
#define XB_XGEN(j)  (2304 + 64 * (j))
#define XB_TOP      3328
#define XB_TOPGEN   3392
#define XCD_BAR_WORDS 3456
#define XB_SPIN_CAP (1u << 18)
DEV unsigned xb_ld(unsigned* p)              { return __hip_atomic_load(p, __ATOMIC_RELAXED, __HIP_MEMORY_SCOPE_AGENT); }
DEV unsigned xb_add(unsigned* p, unsigned v) { return __hip_atomic_fetch_add(p, v, __ATOMIC_RELAXED, __HIP_MEMORY_SCOPE_AGENT); }
DEV unsigned xb_xcc_id() { return (unsigned)__builtin_amdgcn_s_getreg((3 << 11) | 20) & 0xFu; }
#define XB_SPIN(cond, bar) do { unsigned _sp = 0; while (cond) { __builtin_amdgcn_s_sleep(1); \
    if ((++_sp & 255u) == 0u) { if (xb_ld(&(bar)[XB_TMO])) break; if (_sp > XB_SPIN_CAP) { atomicAdd(&(bar)[XB_TMO], 1u); break; } } } } while (0)
struct XcdBarrier { unsigned* bar; unsigned x; volatile LAS unsigned* st; };
DEV XcdBarrier xcd_barrier_post(unsigned* bar, volatile LAS unsigned* st, int tid) {
    XcdBarrier b; b.bar = bar; b.x = xb_xcc_id(); b.st = st;
    if (tid == 0) (void)xb_add(&bar[XB_XCNT(b.x)], 1u);
    return b;
}
DEV void xcd_barrier_complete(unsigned* bar, unsigned x, unsigned& nloc, unsigned& nx) {
    const unsigned G = gridDim.x * gridDim.y * gridDim.z;
    unsigned sum, cnt, mine, sp = 0u;
    for (;;) {
        sum = 0u; cnt = 0u; mine = 0u;
#pragma unroll
        for (unsigned j = 0; j < 16; ++j) { const unsigned c = xb_ld(&bar[XB_XCNT(j)]); sum += c; cnt += (c > 0u) ? 1u : 0u; mine = (j == x) ? c : mine; }
        if (sum == G) break;
        __builtin_amdgcn_s_sleep(1);
        if ((++sp & 255u) == 0u) { if (xb_ld(&bar[XB_TMO])) break; if (sp > XB_SPIN_CAP) { atomicAdd(&bar[XB_TMO], 1u); break; } }
    }
    nloc = mine > 0u ? mine : 1u; nx = cnt > 0u ? cnt : 1u;
}
DEV void xcd_barrier(const XcdBarrier& b, int tid) {
    asm volatile("s_waitcnt vmcnt(0)" ::: "memory");
    __syncthreads();
    if (tid == 0) {
        unsigned* bar = b.bar;
        __builtin_amdgcn_s_waitcnt(0);
        unsigned nloc = b.st[0], nx = b.st[1];
        if (nloc == 0u) { xcd_barrier_complete(bar, b.x, nloc, nx); b.st[0] = nloc; b.st[1] = nx; }
        const unsigned old = xb_add(&bar[XB_XSUB(b.x)], 1u);
        const unsigned gen = old / nloc;
        if (old + 1u == (gen + 1u) * nloc) {
            __builtin_amdgcn_fence(__ATOMIC_RELEASE, "agent");
            asm volatile("s_waitcnt vmcnt(0)" ::: "memory");
            const unsigned og = xb_add(&bar[XB_TOP], 1u);
            const unsigned tg = og / nx;
            if (og + 1u == (tg + 1u) * nx) xb_add(&bar[XB_TOPGEN], 1u);
            else XB_SPIN(xb_ld(&bar[XB_TOPGEN]) == tg, bar);
            __builtin_amdgcn_fence(__ATOMIC_ACQUIRE, "agent");
            xb_add(&bar[XB_XGEN(b.x)], 1u);
            asm volatile("s_waitcnt vmcnt(0)" ::: "memory");
        } else {
            XB_SPIN(xb_ld(&bar[XB_XGEN(b.x)]) == gen, bar);
            __builtin_amdgcn_fence(__ATOMIC_ACQUIRE, "agent");
            asm volatile("s_waitcnt vmcnt(0)" ::: "memory");
        }
    }
    __syncthreads();
}

struct CmId { int off; DEV int operator()(int n) const { return n + off; } };
struct CmE1 { DEV int operator()(int n) const {
    if (n < 384) return n;
    if (n < 416) return PJ_KPE + rope_perm(n - 384);
    if (n < 672) return PJ_GQ + (n - 416);
    if (n < 928) return PJ_GK + (n - 672);
    if (n < 1440) return PJ_GV + (n - 928);
    if (n < 1456) return PJ_GLR + (n - 1440);
    return PJ_R + (n - 1456); } };
struct CmQ { DEV int operator()(int n) const { const int h = n / 96, r = n - h * 96; return r < 64 ? n : h * 96 + 64 + rope_perm(r - 64); } };
struct CmKV { DEV int operator()(int n) const { const int h = n >> 7, r = n & 127; return r < 64 ? h * 64 + r : 512 + h * 64 + (r - 64); } };

template <class CM>
DEV void prep_job(const Ctx& c, const float* W, int ldw, int Ksrc, int Nsrc, const float* gk, float scale, bf16_t* WT, int ldt, const CM cm) {
    LAS float* scr = (LAS float*)(c.lds + c.wave * 8704);
    const int nblk = (Nsrc + 31) / 32, nitems = (Ksrc / 64) * nblk, lane = c.lane;
    for (int it = c.gw; it < nitems; it += c.NGW) {
        const int kb = it / nblk, nb = it - kb * nblk, k0 = kb * 64, n0 = nb * 32;
        const int nr = n0 + (lane & 31);
#pragma unroll 8
        for (int i = 0; i < 32; ++i) {
            const int kk = 2 * i + (lane >> 5);
            float v = (nr < Nsrc) ? W[(size_t)(k0 + kk) * ldw + nr] : 0.f;
            if (gk) v *= gk[k0 + kk];
            scr[kk * 33 + (lane & 31)] = v * scale;
        }
        LDS_WAIT(); asm volatile("" ::: "memory");
        const int cc = lane & 7;
#pragma unroll
        for (int j = 0; j < 4; ++j) {
            const int nl = (lane >> 3) + 8 * j, n = n0 + nl;
            if (n < Nsrc) {
                const int dr = cm(n);
                const LAS float* s = scr + (8 * cc) * 33 + nl;
                u32x4 o; o.x = pk2(s[0], s[33]); o.y = pk2(s[66], s[99]); o.z = pk2(s[132], s[165]); o.w = pk2(s[198], s[231]);
                *(u32x4*)(WT + (size_t)dr * ldt + k0 + 8 * cc) = o;
            }
        }
        LDS_WAIT(); asm volatile("" ::: "memory");
    }
}
DEV void zero_block(const Ctx& c, bf16_t* p, int rows, int cols, int ld) {
    const int cpr = cols / 8, n = rows * cpr;
    unsigned z = 0u; asm volatile("" : "+v"(z));
    for (int i = c.gw * 64 + c.lane; i < n; i += c.NGW * 64) { const int r = i / cpr, cc = i - r * cpr; *(u32x4*)(p + (size_t)r * ld + cc * 8) = (u32x4){z, z, z, z}; }
}

namespace pg8 {
constexpr int BM = 256, BK = 64, HALF = 128, HTB = HALF * BK * 2, STAGE_BYTES = 8 * HTB, NXCD = 8, WGM = 8;
__host__ __device__ __forceinline__ int lds_byte(int r, int c) { const int st = (r >> 4) * 2 + (c >> 5), rr = r & 15, cc = c & 31, ob = rr * 64 + cc * 2; return st * 1024 + (ob ^ (((ob >> 9) & 1) << 5)); }
__host__ __device__ __forceinline__ void stage_rc(int b, int& R, int& C) { const int st = b / 1024, sb = b % 1024, swz = sb ^ (((sb >> 9) & 1) << 5); R = (st >> 1) * 16 + swz / 64; C = (st & 1) * 32 + (swz % 64) / 2; }
__host__ __device__ __forceinline__ int perm32(int rho) { const int n = rho >> 4, i = rho & 15; return 8 * (i >> 2) + 4 * n + (i & 3); }
struct Unit { int pm, pn; };
struct StaticOrder {
    int nM, nN, nwg, G, c;
    DEV void init(int nM_, int nN_, int G_, int c_) { nM = nM_; nN = nN_; nwg = nM * nN; G = G_; c = c_; }
    DEV bool next(int i, Unit& u) const {
        const long L = (long)i * G + c; if (L >= nwg) return false;
        int wgid = (int)L; { const int q = nwg / NXCD, r = nwg % NXCD, xcd = wgid % NXCD, off = wgid / NXCD; wgid = (xcd < r ? xcd * (q + 1) : r * (q + 1) + (xcd - r) * q) + off; }
        const int nig = WGM * nN, gid = wgid / nig, fm = gid * WGM, gsz = (nM - fm) < WGM ? (nM - fm) : WGM;
        u.pm = fm + ((wgid % nig) % gsz); u.pn = (wgid % nig) / gsz; return true;
    }
};
template <class Prob>
DEV void gemm_phase(LAS unsigned char* lds, int tid, const StaticOrder& S, const Prob& P) {
    const int wid = __builtin_amdgcn_readfirstlane(tid >> 6), lane = tid & 63, wr = wid >> 2, wc = wid & 3, fr = lane & 15, fq = lane >> 4;
    const int nt = P.nt, lda = P.lda, ldb = P.ldb;
    unsigned voffA[2], voffB[2];
#pragma unroll
    for (int i = 0; i < 2; ++i) { int R, C; stage_rc(tid * 16 + i * 8192, R, C); const int Rb = (R & ~31) + perm32(R & 31);
        voffA[i] = (unsigned)(R * lda + C) * 2u; voffB[i] = (unsigned)(Rb * ldb + C) * 2u; }
    const size_t kstep = (size_t)(BK * 2);
    const size_t hstepA = (size_t)HALF * lda * 2, hstepB = (size_t)HALF * ldb * 2;
    const unsigned ldsw = (unsigned)wid * 1024u;
    const int aoff = lds_byte(wr * 64 + fr, fq * 8), boff = lds_byte(wc * 32 + fr, fq * 8);
#define PG8_SA(b, h) (((b) * 2 + (h)) * HTB)
#define PG8_SB(b, h) ((4 + (b) * 2 + (h)) * HTB)
#define PG8_STAGE(bufoff, gbase, voff) do { _Pragma("unroll") for (int _i = 0; _i < 2; ++_i) \
        __builtin_amdgcn_global_load_lds((const unsigned*)((const char*)(gbase) + (voff)[_i]), (LAS unsigned*)(lds + (bufoff) + ldsw + _i * 8192), 16, 0, 0); } while (0)
#define PG8_LDA(dst, b, h) do { _Pragma("unroll") for (int m = 0; m < 4; ++m) _Pragma("unroll") for (int k = 0; k < 2; ++k) dst[m][k] = *(const LAS bf16x8*)(lds + PG8_SA(b, h) + aoff + m * 2048 + k * 1024); } while (0)
#define PG8_LDB(dst, b, h) do { _Pragma("unroll") for (int n = 0; n < 2; ++n) _Pragma("unroll") for (int k = 0; k < 2; ++k) dst[n][k] = *(const LAS bf16x8*)(lds + PG8_SB(b, h) + boff + n * 2048 + k * 1024); } while (0)
#define PG8_MMA(ai, bj, At, Bt) do { __builtin_amdgcn_s_setprio(1); _Pragma("unroll") for (int m = 0; m < 4; ++m) _Pragma("unroll") for (int n = 0; n < 2; ++n) _Pragma("unroll") for (int k = 0; k < 2; ++k) \
        acc[ai][bj][m][n] = __builtin_amdgcn_mfma_f32_16x16x32_bf16(Bt[n][k], At[m][k], acc[ai][bj][m][n], 0, 0, 0); __builtin_amdgcn_s_setprio(0); } while (0)
#define PG8_WAIT_V(n) asm volatile("s_waitcnt vmcnt(" #n ")" ::: "memory")
#define PG8_WAIT_L(n) asm volatile("s_waitcnt lgkmcnt(" #n ")" ::: "memory")
#define PG8_BAR __builtin_amdgcn_s_barrier()
#define PG8_SCHED __builtin_amdgcn_sched_barrier(0)
    Unit cur, nxt; int ui = 0;
    if (!S.next(0, cur)) return;
    f32x4 acc[2][2][4][2];
#pragma unroll
    for (int a = 0; a < 2; ++a)
#pragma unroll
        for (int b = 0; b < 2; ++b)
#pragma unroll
            for (int m = 0; m < 4; ++m)
#pragma unroll
                for (int n = 0; n < 2; ++n) acc[a][b][m][n] = (f32x4){0.f, 0.f, 0.f, 0.f};
    bf16x8 At[4][2], B0[2][2], B1[2][2];
    const char* cA = P.aptr(cur); const char* cB = P.bptr(cur);
    PG8_STAGE(PG8_SB(0, 0), cB, voffB); PG8_STAGE(PG8_SA(0, 0), cA, voffA); PG8_STAGE(PG8_SB(0, 1), cB + hstepB, voffB); PG8_STAGE(PG8_SA(0, 1), cA + hstepA, voffA);
    if (wr == 1) PG8_BAR;
    PG8_WAIT_V(4); PG8_BAR;
    PG8_STAGE(PG8_SB(1, 0), cB + kstep, voffB); PG8_STAGE(PG8_SA(1, 0), cA + kstep, voffA); PG8_STAGE(PG8_SB(1, 1), cB + hstepB + kstep, voffB);
    PG8_WAIT_V(6); PG8_BAR;
    for (;;) {
        const bool has_next = S.next(ui + 1, nxt);
        const char* nA = has_next ? P.aptr(nxt) : cA; const char* nB = has_next ? P.bptr(nxt) : cB;
        for (int t = 0; t < nt; t += 2) {
            const bool last = (t == nt - 2);
            const char* a1 = cA + (size_t)(t + 1) * kstep;
            const char* a2 = last ? nA : cA + (size_t)(t + 2) * kstep; const char* b2 = last ? nB : cB + (size_t)(t + 2) * kstep;
            const char* a3 = a2 + kstep; const char* b3 = b2 + kstep;
            PG8_LDB(B0, 0, 0); PG8_SCHED; PG8_LDA(At, 0, 0); PG8_STAGE(PG8_SA(1, 1), a1 + hstepA, voffA);
            PG8_WAIT_L(8); PG8_BAR; PG8_WAIT_L(0); PG8_MMA(0, 0, At, B0); PG8_BAR; PG8_SCHED;
            PG8_LDB(B1, 0, 1); PG8_STAGE(PG8_SB(0, 0), b2, voffB);
            PG8_BAR; PG8_WAIT_L(0); PG8_MMA(0, 1, At, B1); PG8_BAR;
            PG8_LDA(At, 0, 1); PG8_STAGE(PG8_SA(0, 0), a2, voffA);
            PG8_BAR; PG8_WAIT_L(0); PG8_MMA(1, 0, At, B0); PG8_BAR; PG8_SCHED;
            PG8_STAGE(PG8_SB(0, 1), b2 + hstepB, voffB);
            PG8_WAIT_V(6); PG8_BAR; PG8_MMA(1, 1, At, B1); PG8_BAR;
            PG8_LDB(B0, 1, 0); PG8_SCHED; PG8_LDA(At, 1, 0); PG8_STAGE(PG8_SA(0, 1), a2 + hstepA, voffA);
            PG8_WAIT_L(8); PG8_BAR; PG8_WAIT_L(0); PG8_MMA(0, 0, At, B0); PG8_BAR; PG8_SCHED;
            PG8_LDB(B1, 1, 1); PG8_STAGE(PG8_SB(1, 0), b3, voffB);
            PG8_BAR; PG8_WAIT_L(0); PG8_MMA(0, 1, At, B1); PG8_BAR;
            PG8_LDA(At, 1, 1); PG8_STAGE(PG8_SA(1, 0), a3, voffA);
            PG8_BAR; PG8_WAIT_L(0); PG8_MMA(1, 0, At, B0); PG8_BAR; PG8_SCHED;
            PG8_STAGE(PG8_SB(1, 1), b3 + hstepB, voffB);
            PG8_WAIT_V(6); PG8_BAR; PG8_MMA(1, 1, At, B1); PG8_BAR;
        }
        P.epi(acc, cur, wr, wc, fr, fq);
        if (!has_next) break;
#pragma unroll
        for (int a = 0; a < 2; ++a)
#pragma unroll
            for (int b = 0; b < 2; ++b)
#pragma unroll
                for (int m = 0; m < 4; ++m)
#pragma unroll
                    for (int n = 0; n < 2; ++n) acc[a][b][m][n] = (f32x4){0.f, 0.f, 0.f, 0.f};
        cur = nxt; cA = nA; cB = nB; ++ui;
    }
    PG8_WAIT_V(0);
    if (wr == 0) PG8_BAR;
    PG8_BAR;
#undef PG8_SA
#undef PG8_SB
#undef PG8_STAGE
#undef PG8_LDA
#undef PG8_LDB
#undef PG8_MMA
#undef PG8_WAIT_V
#undef PG8_WAIT_L
#undef PG8_BAR
#undef PG8_SCHED
}
}
typedef f32x4 Acc[2][2][4][2];

DEV void st8(bf16_t* p, f32x4 a, f32x4 b) { u32x4 o; o.x = pk2(a[0], a[1]); o.y = pk2(a[2], a[3]); o.z = pk2(b[0], b[1]); o.w = pk2(b[2], b[3]); *(u32x4*)p = o; }
DEV float sq4(f32x4 a) { return a[0] * a[0] + a[1] * a[1] + a[2] * a[2] + a[3] * a[3]; }
DEV void rope8(f32x4& a, f32x4& b, const float* cosT, const float* sinT, int row, int fq) {
    const f32x4 c = *(const f32x4*)(cosT + (size_t)row * 16 + 4 * fq), s = *(const f32x4*)(sinT + (size_t)row * 16 + 4 * fq);
    const f32x4 x1 = a, x2 = b;
    a = x1 * c - x2 * s; b = x2 * c + x1 * s;
}

struct ProbPlain {
    const bf16_t* A; const bf16_t* Bt; int lda, ldb, nt;
    bf16_t* out; int ldo; bf16_t* out2; int split;
    const float* rs;
    int act;
    float* ssq; int nslot;
    DEV const char* aptr(const pg8::Unit& u) const { return (const char*)(A + (size_t)u.pm * 256 * lda); }
    DEV const char* bptr(const pg8::Unit& u) const { return (const char*)(Bt + (size_t)u.pn * 256 * ldb); }
    DEV void epi(const Acc& acc, const pg8::Unit& u, int wr, int wc, int fr, int fq) const {
        bf16_t* o = out; int pn = u.pn; if (pn >= split) { o = out2; pn -= split; }
#pragma unroll
        for (int ai = 0; ai < 2; ++ai)
#pragma unroll
            for (int m = 0; m < 4; ++m) {
                const int row = u.pm * 256 + ai * 128 + wr * 64 + m * 16 + fr;
                const float r = rs ? rs[row] : 1.f;
                float ss = 0.f;
#pragma unroll
                for (int bj = 0; bj < 2; ++bj) {
                    f32x4 v0 = acc[ai][bj][m][0] * r, v1 = acc[ai][bj][m][1] * r;
                    if (act == 1) {
#pragma unroll
                        for (int j = 0; j < 4; ++j) { float a = fmaxf(v0[j], 0.f), b = fmaxf(v1[j], 0.f); v0[j] = a * a; v1[j] = b * b; }
                    }
                    ss += sq4(v0) + sq4(v1);
                    st8(o + (size_t)row * ldo + pn * 256 + bj * 128 + wc * 32 + fq * 8, v0, v1);
                }
                if (ssq) { ss += __shfl_xor(ss, 16); ss += __shfl_xor(ss, 32); if (fq == 0) ssq[(size_t)row * nslot + u.pn * 4 + wc] = ss; }
            }
    }
};
struct ProbE1 {
    const bf16_t* A; const bf16_t* Bt; int lda, ldb, nt;
    bf16_t* proj; const float* rs; float* ssqq; float* ssqkv; const float* cosT; const float* sinT;
    DEV const char* aptr(const pg8::Unit& u) const { return (const char*)(A + (size_t)u.pm * 256 * lda); }
    DEV const char* bptr(const pg8::Unit& u) const { return (const char*)(Bt + (size_t)u.pn * 256 * ldb); }
    DEV void epi(const Acc& acc, const pg8::Unit& u, int wr, int wc, int fr, int fq) const {
#pragma unroll
        for (int ai = 0; ai < 2; ++ai)
#pragma unroll
            for (int m = 0; m < 4; ++m) {
                const int row = u.pm * 256 + ai * 128 + wr * 64 + m * 16 + fr;
                const float r = rs[row];
                float ss0 = 0.f, ss1 = 0.f;
#pragma unroll
                for (int bj = 0; bj < 2; ++bj) {
                    f32x4 v0 = acc[ai][bj][m][0] * r, v1 = acc[ai][bj][m][1] * r;
                    if (bj == 0) ss0 = sq4(v0) + sq4(v1); else ss1 = sq4(v0) + sq4(v1);
                    if (u.pn == 1 && bj == 1 && wc == 0) rope8(v0, v1, cosT, sinT, row, fq);
                    st8(proj + (size_t)row * 2048 + u.pn * 256 + bj * 128 + wc * 32 + fq * 8, v0, v1);
                }
                if (u.pn == 0) { float ss = ss0 + ss1; ss += __shfl_xor(ss, 16); ss += __shfl_xor(ss, 32); if (fq == 0) ssqq[(size_t)row * 4 + wc] = ss; }
                if (u.pn == 1) { float ss = ss0; ss += __shfl_xor(ss, 16); ss += __shfl_xor(ss, 32); if (fq == 0) ssqkv[(size_t)row * 4 + wc] = ss; }
            }
    }
};
struct ProbE2 {
    const bf16_t* proj; const bf16_t* Wuq; const bf16_t* Wukv; int lda, ldb, nt;
    bf16_t* Q; bf16_t* KN; bf16_t* V; const float* ssqq; const float* ssqkv; const float* cosT; const float* sinT;
    DEV const char* aptr(const pg8::Unit& u) const { return (const char*)(proj + (size_t)u.pm * 256 * 2048 + (u.pn < 3 ? PJ_CQ : PJ_CKV)); }
    DEV const char* bptr(const pg8::Unit& u) const { return (const char*)(u.pn < 3 ? Wuq + (size_t)u.pn * 256 * 256 : Wukv + (size_t)(u.pn - 3) * 256 * 256); }
    DEV void epi(const Acc& acc, const pg8::Unit& u, int wr, int wc, int fr, int fq) const {
        const bool isq = u.pn < 3; const int t = u.pn - 3;
#pragma unroll
        for (int ai = 0; ai < 2; ++ai)
#pragma unroll
            for (int m = 0; m < 4; ++m) {
                const int row = u.pm * 256 + ai * 128 + wr * 64 + m * 16 + fr;
                const f32x4 p4 = *(const f32x4*)((isq ? ssqq : ssqkv) + (size_t)row * 4);
                const float r = rsqrtf(((p4[0] + p4[1]) + (p4[2] + p4[3])) * (isq ? (1.f / 256.f) : (1.f / 128.f)) + EPS);
#pragma unroll
                for (int bj = 0; bj < 2; ++bj) {
                    f32x4 v0 = acc[ai][bj][m][0] * r, v1 = acc[ai][bj][m][1] * r;
                    if (isq) {
                        const int g32 = u.pn * 8 + bj * 4 + wc;
                        if (g32 % 3 == 2) rope8(v0, v1, cosT, sinT, row, fq);
                        st8(Q + (size_t)row * 768 + u.pn * 256 + bj * 128 + wc * 32 + fq * 8, v0, v1);
                    } else {
                        bf16_t* o = (t < 2) ? KN : V;
                        st8(o + (size_t)row * 512 + (t & 1) * 256 + bj * 128 + wc * 32 + fq * 8, v0, v1);
                    }
                }
            }
    }
};


struct ProbKV {
    const bf16_t* memn; const bf16_t* xkt; int lda, ldb, nt; bf16_t* KX; bf16_t* VX;
    DEV const char* aptr(const pg8::Unit& u) const { return (const char*)(memn + (size_t)(u.pn >> 3) * 256 * 1024); }
    DEV const char* bptr(const pg8::Unit& u) const { return (const char*)(xkt + ((size_t)(u.pn >> 2) * 1024 + (u.pn & 3) * 256) * 1024); }
    DEV void epi(const Acc& acc, const pg8::Unit& u, int wr, int wc, int fr, int fq) const {
        bf16_t* o = (((u.pn >> 2) & 1) ? VX : KX) + (size_t)(u.pn >> 3) * 256 * 1024;
#pragma unroll
        for (int ai = 0; ai < 2; ++ai)
#pragma unroll
            for (int m = 0; m < 4; ++m) {
                const int row = ai * 128 + wr * 64 + m * 16 + fr;
#pragma unroll
                for (int bj = 0; bj < 2; ++bj) st8(o + (size_t)row * 1024 + (u.pn & 3) * 256 + bj * 128 + wc * 32 + fq * 8, acc[ai][bj][m][0], acc[ai][bj][m][1]);
            }
    }
};

DEV bf16x8 tr_frag(const LAS unsigned char* blk_ks_base, int lane) {
    const int hi = lane >> 5;
    const LAS unsigned char* p = blk_ks_base + ((lane >> 4) & 1) * 32 + (lane & 3) * 8 + (4 * hi + ((lane & 15) >> 2)) * 64;
    const s16x4 lo = __builtin_bit_cast(s16x4, __builtin_amdgcn_ds_read_tr16_b64_v4i16((LAS v4i16_t*)p));
    const s16x4 hh = __builtin_bit_cast(s16x4, __builtin_amdgcn_ds_read_tr16_b64_v4i16((LAS v4i16_t*)(p + 512)));
    return (bf16x8){lo[0], lo[1], lo[2], lo[3], hh[0], hh[1], hh[2], hh[3]};
}
DEV bf16x8 pack8(const f32x16& p, int b) {
    u32x4 o; o.x = pk2(p[b], p[b + 1]); o.y = pk2(p[b + 2], p[b + 3]); o.z = pk2(p[b + 4], p[b + 5]); o.w = pk2(p[b + 6], p[b + 7]);
    return __builtin_bit_cast(bf16x8, o);
}
template <int NC1, int NC2, int NVB, int NDVB, bool CAUSAL>
DEV void flash_unit(const Ctx& c, const bf16_t* Qw, int ldq, const bf16_t* K1, int ldk1, const bf16_t* K2, int ldk2, const bf16_t* Vp, int ldv,
                    bf16_t* Ow, int ldo, int NT, int dvb0, int qrel0, int band0) {
    constexpr int NCH = NC1 + NC2, NKD = NCH / 2, KB = NCH * 1024, VB = NVB * 4096, BUF = KB + VB;
    constexpr int NKP = 64 * NCH, KPT = (NKP + 511) / 512, NVP = 256 * NVB, VPT = (NVP + 511) / 512;
    const int tid = c.tid, lane = c.lane, r32 = lane & 31, hi = lane >> 5;
    LAS unsigned char* lds = c.lds;
    bf16x8 qr[NKD];
#pragma unroll
    for (int d0 = 0; d0 < NKD; ++d0) qr[d0] = *(const bf16x8*)(Qw + (size_t)r32 * ldq + d0 * 16 + hi * 8);
    auto g_load = [&](int t, int buf) {
        LAS unsigned char* kb = lds + buf * BUF; LAS unsigned char* vb = kb + KB;
#pragma unroll
        for (int i = 0; i < KPT; ++i) { const int p = tid + 512 * i;
            if (p < NKP) { const int ch = p >> 6, row = t * 64 + (p & 63);
                const bf16_t* src = (ch < NC1) ? K1 + (size_t)row * ldk1 + ch * 8 : K2 + (size_t)row * ldk2 + (ch - NC1) * 8;
                __builtin_amdgcn_global_load_lds((const unsigned*)src, (LAS unsigned*)(kb + (c.wave * 64 + 512 * i) * 16), 16, 0, 0); } }
#pragma unroll
        for (int i = 0; i < VPT; ++i) { const int p = tid + 512 * i;
            if (p < NVP) { const int blk = p >> 8, row = t * 64 + ((p >> 2) & 63), c4 = p & 3;
                __builtin_amdgcn_global_load_lds((const unsigned*)(Vp + (size_t)row * ldv + blk * 32 + c4 * 8), (LAS unsigned*)(vb + (c.wave * 64 + 512 * i) * 16), 16, 0, 0); } }
    };
    float m_run = -INFINITY, l_run = 0.f;
    f32x16 oT[NDVB];
#pragma unroll
    for (int b = 0; b < NDVB; ++b)
#pragma unroll
        for (int r = 0; r < 16; ++r) oT[b][r] = 0.f;
    g_load(0, 0); __syncthreads();
    for (int t = 0; t < NT; ++t) {
        const int buf = t & 1;
        if (t + 1 < NT) g_load(t + 1, buf ^ 1);
        bool active = true;
        if (CAUSAL) { const int jb = t - band0; if (jb >= 0 && 64 * jb > qrel0 + 31) active = false; }
        if (active) {
            const LAS unsigned char* Kb = lds + buf * BUF; const LAS unsigned char* Vb = Kb + KB;
            f32x16 p0, p1;
#pragma unroll
            for (int r = 0; r < 16; ++r) { p0[r] = 0.f; p1[r] = 0.f; }
#pragma unroll
            for (int d0 = 0; d0 < NKD; ++d0) {
                const bf16x8 k0 = *(const LAS bf16x8*)(Kb + (2 * d0 + hi) * 1024 + r32 * 16);
                const bf16x8 k1 = *(const LAS bf16x8*)(Kb + (2 * d0 + hi) * 1024 + r32 * 16 + 512);
                p0 = __builtin_amdgcn_mfma_f32_32x32x16_bf16(k0, qr[d0], p0, 0, 0, 0);
                p1 = __builtin_amdgcn_mfma_f32_32x32x16_bf16(k1, qr[d0], p1, 0, 0, 0);
            }
            if (CAUSAL) { const int jb = t - band0;
                if (jb >= 0) { const int qrel = qrel0 + r32, kb = 64 * jb + 4 * hi;
#pragma unroll
                    for (int r = 0; r < 16; ++r) { const int kv = kb + (r & 3) + 8 * (r >> 2); if (kv > qrel) p0[r] = -INFINITY; if (kv + 32 > qrel) p1[r] = -INFINITY; } } }
            float mx = fmaxf(p0[0], p1[0]);
#pragma unroll
            for (int r = 1; r < 16; ++r) mx = fmaxf(mx, fmaxf(p0[r], p1[r]));
            mx = swap32_max(mx);
            const float mnew = fmaxf(m_run, mx);
            const float alpha = __builtin_amdgcn_exp2f(m_run - mnew);
            float ps = 0.f;
#pragma unroll
            for (int r = 0; r < 16; ++r) { p0[r] = __builtin_amdgcn_exp2f(p0[r] - mnew); p1[r] = __builtin_amdgcn_exp2f(p1[r] - mnew); ps += p0[r] + p1[r]; }
            l_run = l_run * alpha + ps; m_run = mnew;
#pragma unroll
            for (int b = 0; b < NDVB; ++b)
#pragma unroll
                for (int r = 0; r < 16; ++r) oT[b][r] *= alpha;
            bf16x8 pw[4]; pw[0] = pack8(p0, 0); pw[1] = pack8(p0, 8); pw[2] = pack8(p1, 0); pw[3] = pack8(p1, 8);
#pragma unroll
            for (int b = 0; b < NDVB; ++b)
#pragma unroll
                for (int ks = 0; ks < 4; ++ks) {
                    const bf16x8 vf = tr_frag(Vb + (dvb0 + b) * 4096 + ks * 1024, lane);
                    oT[b] = __builtin_amdgcn_mfma_f32_32x32x16_bf16(vf, pw[ks], oT[b], 0, 0, 0);
                }
        }
        __syncthreads();
    }
    const float inv = 1.f / swap32_sum(l_run);
#pragma unroll
    for (int b = 0; b < NDVB; ++b)
#pragma unroll
        for (int g = 0; g < 4; ++g) {
            u32x2 o; o.x = pk2(oT[b][4 * g] * inv, oT[b][4 * g + 1] * inv); o.y = pk2(oT[b][4 * g + 2] * inv, oT[b][4 * g + 3] * inv);
            *(u32x2*)(Ow + (size_t)r32 * ldo + b * 32 + 8 * g + 4 * hi) = o;
        }
}


DEV float gla_cumdecay(const Ctx& c, const bf16_t* PJ, const float* wg, const float* bg, int t0, int head, LAS float* Bm, LAS float* tot, float (&bl)[8]) {
    const int ch = c.lane, w = c.wave;
    float wcol[16];
#pragma unroll
    for (int j = 0; j < 16; ++j) wcol[j] = wg[j * 256 + head * 64 + ch];
    const float bias = bg[head * 64 + ch];
    float run = 0.f;
#pragma unroll
    for (int i = 0; i < 8; ++i) {
        const bf16_t* gl = PJ + (size_t)(t0 + 8 * w + i) * 2048 + PJ_GLR;
        float x = bias;
#pragma unroll
        for (int j = 0; j < 16; ++j) x += bf1(gl[j]) * wcol[j];
        run += logsigmoid_f(x) * (1.f / 16.f);
        bl[i] = run;
    }
    tot[w * 64 + ch] = run;
    __syncthreads();
    float off = 0.f, bend = 0.f;
#pragma unroll
    for (int ww = 0; ww < 8; ++ww) { const float tv = tot[ww * 64 + ch]; if (ww < w) off += tv; bend += tv; }
#pragma unroll
    for (int i = 0; i < 8; ++i) { bl[i] += off; Bm[(8 * w + i) * 64 + ch] = bl[i]; }
    return bend;
}
constexpr int GL_BM = 0, GL_TOT = 16384, GL_QI = 20480, GL_KI = 28672, GL_VI = 36864, GL_RED = 53248;
DEV void gla_load_v(const Ctx& c, const bf16_t* PJ, int t0, int head, LAS unsigned char* VI) {
#pragma unroll
    for (int i = 0; i < 2; ++i) { const int p = c.tid + 512 * i, blk = p >> 8, row = (p >> 2) & 63, c4 = p & 3;
        *(LAS u32x4*)(VI + p * 16) = *(const u32x4*)(PJ + (size_t)(t0 + row) * 2048 + PJ_GV + head * 128 + blk * 32 + c4 * 8); }
}
DEV void gla_a_unit(const Ctx& c, const bf16_t* PJ, const float* wg, const float* bg, int cidx, int head, bf16_t* GST, float* GDEC) {
    LAS unsigned char* lds = c.lds; const int t0 = cidx * 64, ch = c.lane, w = c.wave;
    float bl[8];
    const float bend = gla_cumdecay(c, PJ, wg, bg, t0, head, (LAS float*)(lds + GL_BM), (LAS float*)(lds + GL_TOT), bl);
#pragma unroll
    for (int i = 0; i < 8; ++i) { const int t = 8 * w + i;
        const float kv = bf1(PJ[(size_t)(t0 + t) * 2048 + PJ_GK + head * 64 + ch]) * __expf(bend - bl[i]);
        *(LAS bf16_t*)(lds + GL_KI + (ch >> 5) * 4096 + t * 64 + (ch & 31) * 2) = f2bf(kv); }
    gla_load_v(c, PJ, t0, head, lds + GL_VI);
    if (w == 0) GDEC[(cidx * 4 + head) * 64 + ch] = __expf(bend);
    __syncthreads();
    const int dvb = w >> 1, dkb = w & 1, r32 = c.lane & 31, hi = c.lane >> 5;
    f32x16 acc;
#pragma unroll
    for (int r = 0; r < 16; ++r) acc[r] = 0.f;
#pragma unroll
    for (int ks = 0; ks < 4; ++ks) {
        const bf16x8 a = tr_frag(lds + GL_VI + dvb * 4096 + ks * 1024, c.lane), b = tr_frag(lds + GL_KI + dkb * 4096 + ks * 1024, c.lane);
        acc = __builtin_amdgcn_mfma_f32_32x32x16_bf16(a, b, acc, 0, 0, 0);
    }
    bf16_t* o = GST + ((size_t)(cidx * 4 + head) * 128 + dvb * 32) * 64 + dkb * 32 + r32;
#pragma unroll
    for (int r = 0; r < 16; ++r) o[(size_t)crow(r, hi) * 64] = f2bf(acc[r]);
    __syncthreads();
}
DEV void gla_scan(const Ctx& c, bf16_t* GST, const float* GDEC) {
    const int e = c.vcu * NTHREADS + c.tid;
    if (e >= 4 * 128 * 64) return;
    const int hh = e >> 13, dk = e & 63, rem = e & 8191;
    float st = 0.f;
    for (int cb = 0; cb < 256; cb += 8) {
        float u[8], a[8];
#pragma unroll
        for (int i = 0; i < 8; ++i) { u[i] = bf1(GST[(size_t)((cb + i) * 4 + hh) * 8192 + rem]); a[i] = GDEC[((cb + i) * 4 + hh) * 64 + dk]; }
#pragma unroll
        for (int i = 0; i < 8; ++i) { GST[(size_t)((cb + i) * 4 + hh) * 8192 + rem] = f2bf(st); st = a[i] * st + u[i]; }
    }
}
DEV void gla_c_unit(const Ctx& c, const bf16_t* PJ, const float* wg, const float* bg, const float* gnorm, int cidx, int head, const bf16_t* GST, bf16_t* CAT) {
    LAS unsigned char* lds = c.lds; const int t0 = cidx * 64, ch = c.lane, w = c.wave;
    float bl[8];
    (void)gla_cumdecay(c, PJ, wg, bg, t0, head, (LAS float*)(lds + GL_BM), (LAS float*)(lds + GL_TOT), bl);
#pragma unroll
    for (int i = 0; i < 8; ++i) { const int t = 8 * w + i;
        const float qv = bf1(PJ[(size_t)(t0 + t) * 2048 + PJ_GQ + head * 64 + ch]) * __expf(bl[i]) * 0.125f;
        const float kv = bf1(PJ[(size_t)(t0 + t) * 2048 + PJ_GK + head * 64 + ch]) * __expf(fminf(-bl[i], 60.f));
        *(LAS bf16_t*)(lds + GL_QI + (ch >> 3) * 1024 + t * 16 + (ch & 7) * 2) = f2bf(qv);
        *(LAS bf16_t*)(lds + GL_KI + (ch >> 3) * 1024 + t * 16 + (ch & 7) * 2) = f2bf(kv); }
    gla_load_v(c, PJ, t0, head, lds + GL_VI);
    __syncthreads();
    const int dvb = w >> 1, tb = w & 1, r32 = c.lane & 31, hi = c.lane >> 5;
    bf16x8 qf[4];
#pragma unroll
    for (int d0 = 0; d0 < 4; ++d0) qf[d0] = *(const LAS bf16x8*)(lds + GL_QI + (2 * d0 + hi) * 1024 + (tb * 32 + r32) * 16);
    bf16x8 pw[4];
#pragma unroll
    for (int sb = 0; sb < 2; ++sb) {
        f32x16 aT;
#pragma unroll
        for (int r = 0; r < 16; ++r) aT[r] = 0.f;
        if (sb <= tb) {
#pragma unroll
            for (int d0 = 0; d0 < 4; ++d0) {
                const bf16x8 kf = *(const LAS bf16x8*)(lds + GL_KI + (2 * d0 + hi) * 1024 + (sb * 32 + r32) * 16);
                aT = __builtin_amdgcn_mfma_f32_32x32x16_bf16(kf, qf[d0], aT, 0, 0, 0);
            }
            if (sb == tb) {
#pragma unroll
                for (int r = 0; r < 16; ++r) if (crow(r, hi) > r32) aT[r] = 0.f;
            }
        }
        pw[2 * sb] = pack8(aT, 0); pw[2 * sb + 1] = pack8(aT, 8);
    }
    f32x16 oT;
#pragma unroll
    for (int r = 0; r < 16; ++r) oT[r] = 0.f;
#pragma unroll
    for (int ks = 0; ks < 4; ++ks) {
        if (ks < 2 * (tb + 1)) { const bf16x8 vf = tr_frag(lds + GL_VI + dvb * 4096 + ks * 1024, c.lane); oT = __builtin_amdgcn_mfma_f32_32x32x16_bf16(vf, pw[ks], oT, 0, 0, 0); }
    }
    const bf16_t* stp = GST + ((size_t)(cidx * 4 + head) * 128 + dvb * 32 + r32) * 64 + hi * 8;
#pragma unroll
    for (int d0 = 0; d0 < 4; ++d0) { const bf16x8 sf = *(const bf16x8*)(stp + d0 * 16); oT = __builtin_amdgcn_mfma_f32_32x32x16_bf16(sf, qf[d0], oT, 0, 0, 0); }
    float my = 0.f;
#pragma unroll
    for (int r = 0; r < 16; ++r) my += oT[r] * oT[r];
    my = swap32_sum(my);
    LAS float* red = (LAS float*)(lds + GL_RED);
    if (hi == 0) red[dvb * 64 + tb * 32 + r32] = my;
    __syncthreads();
    const int t = tb * 32 + r32;
    const float rs = rsqrtf((red[t] + red[64 + t] + red[128 + t] + red[192 + t]) * (1.f / 128.f) + EPS);
#pragma unroll
    for (int g = 0; g < 4; ++g) {
        const int dv = dvb * 32 + 8 * g + 4 * hi;
        const u32x2 rr = *(const u32x2*)(PJ + (size_t)(t0 + t) * 2048 + PJ_R + head * 128 + dv);
        const f32x4 gn = *(const f32x4*)(gnorm + dv);
        const float v0 = oT[4 * g] * rs * gn[0] * silu_f(bflo(rr.x)), v1 = oT[4 * g + 1] * rs * gn[1] * silu_f(bfhi(rr.x));
        const float v2 = oT[4 * g + 2] * rs * gn[2] * silu_f(bflo(rr.y)), v3 = oT[4 * g + 3] * rs * gn[3] * silu_f(bfhi(rr.y));
        u32x2 o; o.x = pk2(v0, v1); o.y = pk2(v2, v3);
        *(u32x2*)(CAT + (size_t)(t0 + t) * 1024 + 512 + head * 128 + dv) = o;
    }
    __syncthreads();
}


DEV void conv_phase(const Ctx& c, const bf16_t* XM, const float* convw, const float* convb, const float* G12  , const float* bgates,
                    bf16_t* XC, float* gates) {
    LAS float* gl = (LAS float*)c.lds;
    for (int i = c.tid; i < 16 * 1024 / 4; i += NTHREADS) *(LAS f32x4*)(gl + 4 * i) = *(const f32x4*)(G12 + 4 * i);
    __syncthreads();
    for (int blk = c.gw; blk < S / 8; blk += c.NGW) {
        const int t0 = blk * 8;
        float ga[8][8];
#pragma unroll
        for (int rr = 0; rr < 8; ++rr)
#pragma unroll
            for (int g = 0; g < 8; ++g) ga[rr][g] = 0.f;
#pragma unroll 1
        for (int j = 0; j < 4; ++j) {
            const int ch = 4 * c.lane + 256 * j;
            const f32x4 cb = *(const f32x4*)(convb + ch);
            f32x4 cw[4];
#pragma unroll
            for (int i = 0; i < 4; ++i) cw[i] = *(const f32x4*)(convw + i * 1024 + ch);
            f32x4 w1[8], w2[8];
#pragma unroll
            for (int g = 0; g < 8; ++g) { w1[g] = *(const LAS f32x4*)(gl + g * 1024 + ch); w2[g] = *(const LAS f32x4*)(gl + (8 + g) * 1024 + ch); }
            f32x4 win[4];
#pragma unroll
            for (int i = 0; i < 3; ++i) {
                const int t = t0 - 3 + i;
                if (t >= 0) { const u32x2 mm = *(const u32x2*)(XM + (size_t)t * 1024 + ch); win[i] = (f32x4){bflo(mm.x), bfhi(mm.x), bflo(mm.y), bfhi(mm.y)}; }
                else win[i] = (f32x4){0.f, 0.f, 0.f, 0.f};
            }
#pragma unroll
            for (int rr = 0; rr < 8; ++rr) {
                const int t = t0 + rr;
                const u32x2 mm = *(const u32x2*)(XM + (size_t)t * 1024 + ch);
                win[3] = (f32x4){bflo(mm.x), bfhi(mm.x), bflo(mm.y), bfhi(mm.y)};
                const f32x4 y = cb + cw[0] * win[0] + cw[1] * win[1] + cw[2] * win[2] + cw[3] * win[3];
                f32x4 xc;
#pragma unroll
                for (int e = 0; e < 4; ++e) xc[e] = y[e] / (1.f + __expf(-y[e]));
                u32x2 o; o.x = pk2(xc[0], xc[1]); o.y = pk2(xc[2], xc[3]);
                *(u32x2*)(XC + (size_t)t * 1024 + ch) = o;
#pragma unroll
                for (int g = 0; g < 8; ++g)
                    ga[rr][g] += xc[0] * w1[g][0] + xc[1] * w1[g][1] + xc[2] * w1[g][2] + xc[3] * w1[g][3] + win[3][0] * w2[g][0] + win[3][1] * w2[g][1] + win[3][2] * w2[g][2] + win[3][3] * w2[g][3];
                win[0] = win[1]; win[1] = win[2]; win[2] = win[3];
            }
        }
#pragma unroll
        for (int rr = 0; rr < 8; ++rr) {
            float v = 0.f;
#pragma unroll
            for (int g = 0; g < 8; ++g) { const float sg = wave_sum(ga[rr][g]); if (c.lane == g) v = sg; }
            if (c.lane < 8) gates[(size_t)(t0 + rr) * 8 + c.lane] = v + bgates[c.lane];
        }
    }
    __syncthreads();
}
DEV void gatefold_job(const Ctx& c, const float* wq, const float* wk, const float* wv, const float* Wg, float* G12) {
    for (int i = c.gw * 64 + c.lane; i < 16 * 1024; i += c.NGW * 64) {
        const int g16 = i >> 10, ch = i & 1023, hh = ch >> 8, d = ch & 255, g = g16 & 7;
        float acc = 0.f;
        if (g16 < 8) { const float* a = wq + ((size_t)hh * 256 + d) * 256; const float* b = wk + ((size_t)hh * 256 + d) * 256;
            for (int e = 0; e < 256; ++e) acc += a[e] * Wg[(size_t)(hh * 768 + e) * 8 + g] + b[e] * Wg[(size_t)(hh * 768 + 256 + e) * 8 + g]; }
        else { const float* a = wv + ((size_t)hh * 256 + d) * 256;
            for (int e = 0; e < 256; ++e) acc += a[e] * Wg[(size_t)(hh * 768 + 512 + e) * 8 + g]; }
        G12[i] = acc;
    }
}
struct ProbO3 {
    const bf16_t* XC; const bf16_t* XM; const bf16_t* W3; int lda, ldb, nt; bf16_t* MQ; bf16_t* MK; bf16_t* MV;
    DEV const char* aptr(const pg8::Unit& u) const { return (const char*)(((u.pn >> 2) == 2 ? XM : XC) + (size_t)u.pm * 256 * 1024 + (u.pn & 3) * 256); }
    DEV const char* bptr(const pg8::Unit& u) const { return (const char*)(W3 + (size_t)u.pn * 65536); }
    DEV void epi(const Acc& acc, const pg8::Unit& u, int wr, int wc, int fr, int fq) const {
        const int which = u.pn >> 2; bf16_t* o = MQ + (size_t)which * (16u << 20) + (u.pn & 3) * 256;
#pragma unroll
        for (int ai = 0; ai < 2; ++ai)
#pragma unroll
            for (int m = 0; m < 4; ++m) {
                const int row = u.pm * 256 + ai * 128 + wr * 64 + m * 16 + fr;
#pragma unroll
                for (int bj = 0; bj < 2; ++bj) st8(o + (size_t)row * 1024 + bj * 128 + wc * 32 + fq * 8, acc[ai][bj][m][0], acc[ai][bj][m][1]);
            }
    }
};


constexpr int ML_ARR = 131072, ML_BT = ML_ARR, ML_GT = ML_ARR + 1024, ML_CM = ML_ARR + 2048, ML_WT = ML_ARR + 3072, ML_SCR = ML_ARR + 4096, ML_LN = ML_ARR + 4352;
constexpr size_t ML_MSTAT_G = 0, ML_MSTAT_M = 4096, ML_NLOC = 8192;
DEV void mlstm_tokens(const Ctx& c, const float* gates, int t0, int head, float m_in, float& bend, float& gmax) {
    LAS float* Bt = (LAS float*)(c.lds + ML_BT); LAS float* Gt = (LAS float*)(c.lds + ML_GT); LAS float* CMt = (LAS float*)(c.lds + ML_CM); LAS float* scr = (LAS float*)(c.lds + ML_SCR);
    const int tid = c.tid, lane = c.lane, w = c.wave; const bool act = tid < 256;
    float v = act ? logsigmoid_f(gates[(size_t)(t0 + tid) * 8 + 4 + head]) : 0.f;
    const float ii = act ? gates[(size_t)(t0 + tid) * 8 + head] : 0.f;
#pragma unroll
    for (int o = 1; o < 64; o <<= 1) { const float t = __shfl_up(v, o); if (lane >= o) v += t; }
    if (lane == 63 && w < 4) scr[w] = v;
    __syncthreads();
    float off = 0.f;
#pragma unroll
    for (int ww = 0; ww < 4; ++ww) if (ww < w) off += scr[ww];
    const float b = v + off, g = ii - b;
    float mx = g;
#pragma unroll
    for (int o = 1; o < 64; o <<= 1) { const float t = __shfl_up(mx, o); if (lane >= o) mx = fmaxf(mx, t); }
    if (lane == 63 && w < 4) scr[8 + w] = mx;
    __syncthreads();
    float pm = m_in;
#pragma unroll
    for (int ww = 0; ww < 4; ++ww) if (ww < w) pm = fmaxf(pm, scr[8 + ww]);
    if (act) { Bt[tid] = b; Gt[tid] = g; CMt[tid] = fmaxf(mx, pm); }
    bend = (scr[0] + scr[1]) + (scr[2] + scr[3]); gmax = fmaxf(fmaxf(scr[8], scr[9]), fmaxf(scr[10], scr[11]));
    __syncthreads();
}
DEV void mlstm_a_unit(const Ctx& c, const float* gates, const bf16_t* MK, const bf16_t* MV, int cidx, int head, bf16_t* CST, float* MST) {
    LAS unsigned char* lds = c.lds; const int t0 = cidx * 256, tid = c.tid, lane = c.lane, w = c.wave, r32 = lane & 31, hi = lane >> 5;
    float bend, G;
    mlstm_tokens(c, gates, t0, head, -INFINITY, bend, G);
    LAS float* Gt = (LAS float*)(lds + ML_GT); LAS float* Wt = (LAS float*)(lds + ML_WT);
    if (tid < 256) Wt[tid] = __expf(Gt[tid] - G);
    if (tid == 0) { MST[ML_MSTAT_G + (cidx * 4 + head) * 2] = G; MST[ML_MSTAT_G + (cidx * 4 + head) * 2 + 1] = bend; }
    const int dvb0 = (w >> 1) * 2, dkb0 = (w & 1) * 4;
    f32x16 acc[2][4];
#pragma unroll
    for (int i = 0; i < 2; ++i)
#pragma unroll
        for (int jj = 0; jj < 4; ++jj)
#pragma unroll
            for (int r = 0; r < 16; ++r) acc[i][jj][r] = 0.f;
    float nl = 0.f;
    for (int kt = 0; kt < 4; ++kt) {
        __syncthreads();
#pragma unroll 1
        for (int i = 0; i < 4; ++i) {
            const int p = tid + 512 * i, blk = p >> 8, row = (p >> 2) & 63, c4 = p & 3;
            const size_t go = (size_t)(t0 + 64 * kt + row) * 1024 + head * 256 + blk * 32 + c4 * 8;
            __builtin_amdgcn_global_load_lds((const unsigned*)(MV + go), (LAS unsigned*)(lds + (w * 64 + 512 * i) * 16), 16, 0, 0);
            const u32x4 kk = *(const u32x4*)(MK + go);
            const float ws = Wt[64 * kt + row];
            u32x4 o; o.x = pk2(bflo(kk.x) * ws, bfhi(kk.x) * ws); o.y = pk2(bflo(kk.y) * ws, bfhi(kk.y) * ws); o.z = pk2(bflo(kk.z) * ws, bfhi(kk.z) * ws); o.w = pk2(bflo(kk.w) * ws, bfhi(kk.w) * ws);
            *(LAS u32x4*)(lds + 32768 + p * 16) = o;
        }
        __syncthreads();
#pragma unroll
        for (int ks = 0; ks < 4; ++ks) {
            bf16x8 a[2], b[4];
#pragma unroll
            for (int i = 0; i < 2; ++i) a[i] = tr_frag(lds + (dvb0 + i) * 4096 + ks * 1024, lane);
#pragma unroll
            for (int jj = 0; jj < 4; ++jj) b[jj] = tr_frag(lds + 32768 + (dkb0 + jj) * 4096 + ks * 1024, lane);
#pragma unroll
            for (int i = 0; i < 2; ++i)
#pragma unroll
                for (int jj = 0; jj < 4; ++jj) acc[i][jj] = __builtin_amdgcn_mfma_f32_32x32x16_bf16(a[i], b[jj], acc[i][jj], 0, 0, 0);
        }
        if (tid < 256) { const LAS bf16_t* kc = (const LAS bf16_t*)(lds + 32768 + (tid >> 5) * 4096 + (tid & 31) * 2);
            for (int row = 0; row < 64; ++row) nl += bf1(kc[row * 32]); }
    }
    bf16_t* o = CST + (size_t)(cidx * 4 + head) * 65536;
#pragma unroll
    for (int i = 0; i < 2; ++i)
#pragma unroll
        for (int jj = 0; jj < 4; ++jj)
#pragma unroll
            for (int r = 0; r < 16; ++r) o[(size_t)((dvb0 + i) * 32 + crow(r, hi)) * 256 + (dkb0 + jj) * 32 + r32] = f2bf(acc[i][jj][r]);
    if (tid < 256) MST[ML_NLOC + (size_t)(cidx * 4 + head) * 256 + tid] = nl;
    __syncthreads();
}
DEV void mlstm_scan(const Ctx& c, bf16_t* CST, float* MST) {
    const int gidx = c.vcu * NTHREADS + c.tid;
#pragma unroll 1
    for (int rep = 0; rep < 3; ++rep) {
        const int e = rep < 2 ? gidx + rep * 131072 : gidx;
        if (rep == 2 && gidx >= 1024) break;
        if (rep < 2 && e >= 262144) continue;
        const int hh = rep < 2 ? (e >> 16) : (e >> 8); const int el = rep < 2 ? (e & 65535) : (e & 255);
        float m = 0.f, st = 0.f;
        for (int cb = 0; cb < 63; cb += 7) {
            float u[7], G[7], be[7];
#pragma unroll
            for (int i = 0; i < 7; ++i) { const int ci = (cb + i) * 4 + hh;
                u[i] = rep < 2 ? bf1(CST[(size_t)ci * 65536 + el]) : MST[ML_NLOC + (size_t)ci * 256 + el];
                G[i] = MST[ML_MSTAT_G + ci * 2]; be[i] = MST[ML_MSTAT_G + ci * 2 + 1]; }
#pragma unroll
            for (int i = 0; i < 7; ++i) { const int ci = (cb + i) * 4 + hh;
                const float M = fmaxf(m, G[i]);
                st = __expf(m - M) * st + __expf(G[i] - M) * u[i];
                m = be[i] + M;
                if (rep < 2) CST[(size_t)ci * 65536 + el] = f2bf(st); else MST[ML_NLOC + (size_t)ci * 256 + el] = st;
                if (rep == 2 && el == 0) MST[ML_MSTAT_M + ci] = m; }
        }
    }
}
DEV void mlstm_c_unit(const Ctx& c, const float* gates, const bf16_t* MQ, const bf16_t* MK, const bf16_t* MV, const bf16_t* CST, const float* MST,
                      const bf16_t* XC, const bf16_t* Z, const float* ghn, const float* skip, bf16_t* OUTM, int cidx, int head, int rhf) {
    constexpr int KB = 32768, BUF = 65536;
    LAS unsigned char* lds = c.lds; const int t0 = cidx * 256, tid = c.tid, lane = c.lane, w = c.wave, r32 = lane & 31, hi = lane >> 5;
    const int rg = w >> 1, dvh = w & 1;
    const float m_in = cidx > 0 ? MST[ML_MSTAT_M + (cidx - 1) * 4 + head] : 0.f;
    float bend, gmx;
    mlstm_tokens(c, gates, t0, head, m_in, bend, gmx);
    LAS float* Bt = (LAS float*)(lds + ML_BT); LAS float* Gt = (LAS float*)(lds + ML_GT); LAS float* CMt = (LAS float*)(lds + ML_CM); LAS float* Nt = (LAS float*)(lds + ML_WT);
    if (tid < 256) Nt[tid] = cidx > 0 ? MST[ML_NLOC + (size_t)((cidx - 1) * 4 + head) * 256 + tid] : 0.f;
    auto g_load = [&](int kt, int buf) {
        LAS unsigned char* kb = lds + buf * BUF; LAS unsigned char* vb = kb + KB;
#pragma unroll
        for (int i = 0; i < 4; ++i) { const int p = tid + 512 * i;
            { const int ch = p >> 6, row = t0 + kt * 64 + (p & 63);
              __builtin_amdgcn_global_load_lds((const unsigned*)(MK + (size_t)row * 1024 + head * 256 + ch * 8), (LAS unsigned*)(kb + (w * 64 + 512 * i) * 16), 16, 0, 0); }
            { const int blk = p >> 8, row = t0 + kt * 64 + ((p >> 2) & 63), c4 = p & 3;
              __builtin_amdgcn_global_load_lds((const unsigned*)(MV + (size_t)row * 1024 + head * 256 + blk * 32 + c4 * 8), (LAS unsigned*)(vb + (w * 64 + 512 * i) * 16), 16, 0, 0); } }
    };
    const int NT = 2 * rhf + 2;
    g_load(0, 0);
    const int tl = 128 * rhf + 32 * rg + r32;
    bf16x8 qr[16];
    { const bf16_t* qp = MQ + (size_t)(t0 + tl) * 1024 + head * 256 + hi * 8;
#pragma unroll
      for (int d0 = 0; d0 < 16; ++d0) qr[d0] = *(const bf16x8*)(qp + d0 * 16); }
    __syncthreads();
    const float Mt = CMt[tl], bt = Bt[tl];
    f32x16 oT[4];
#pragma unroll
    for (int b = 0; b < 4; ++b)
#pragma unroll
        for (int r = 0; r < 16; ++r) oT[b][r] = 0.f;
    float den_inter = 0.f;
    if (cidx > 0) {
        const float winter = __expf(m_in - Mt);
        const bf16_t* cp = CST + (size_t)((cidx - 1) * 4 + head) * 65536 + (size_t)(dvh * 128 + r32) * 256 + hi * 8;
#pragma unroll
        for (int b = 0; b < 4; ++b)
#pragma unroll
            for (int d0 = 0; d0 < 16; ++d0) { const bf16x8 cf = *(const bf16x8*)(cp + (size_t)b * 32 * 256 + d0 * 16); oT[b] = __builtin_amdgcn_mfma_f32_32x32x16_bf16(cf, qr[d0], oT[b], 0, 0, 0); }
#pragma unroll
        for (int b = 0; b < 4; ++b)
#pragma unroll
            for (int r = 0; r < 16; ++r) oT[b][r] *= winter;
        float qn = 0.f;
#pragma unroll
        for (int d0 = 0; d0 < 16; ++d0) { const u32x4 qq = __builtin_bit_cast(u32x4, qr[d0]); const LAS float* np = Nt + d0 * 16 + hi * 8;
            qn += bflo(qq.x) * np[0] + bfhi(qq.x) * np[1] + bflo(qq.y) * np[2] + bfhi(qq.y) * np[3] + bflo(qq.z) * np[4] + bfhi(qq.z) * np[5] + bflo(qq.w) * np[6] + bfhi(qq.w) * np[7]; }
        den_inter = winter * swap32_sum(qn);
    }
    float dsum = 0.f;
    for (int kt = 0; kt < NT; ++kt) {
        const int buf = kt & 1;
        if (kt + 1 < NT) g_load(kt + 1, buf ^ 1);
        if (64 * kt <= 128 * rhf + 32 * rg + 31) {
            const LAS unsigned char* Kb = lds + buf * BUF; const LAS unsigned char* Vb = Kb + KB;
            f32x16 p0, p1;
#pragma unroll
            for (int r = 0; r < 16; ++r) { p0[r] = 0.f; p1[r] = 0.f; }
#pragma unroll
            for (int d0 = 0; d0 < 16; ++d0) {
                const bf16x8 k0 = *(const LAS bf16x8*)(Kb + (2 * d0 + hi) * 1024 + r32 * 16);
                const bf16x8 k1 = *(const LAS bf16x8*)(Kb + (2 * d0 + hi) * 1024 + r32 * 16 + 512);
                p0 = __builtin_amdgcn_mfma_f32_32x32x16_bf16(k0, qr[d0], p0, 0, 0, 0);
                p1 = __builtin_amdgcn_mfma_f32_32x32x16_bf16(k1, qr[d0], p1, 0, 0, 0);
            }
#pragma unroll
            for (int q4 = 0; q4 < 4; ++q4) {
                const int s0 = 64 * kt + 8 * q4 + 4 * hi;
                const f32x4 g0 = *(const LAS f32x4*)(Gt + s0), g1 = *(const LAS f32x4*)(Gt + s0 + 32);
#pragma unroll
                for (int e = 0; e < 4; ++e) {
                    const float w0 = (s0 + e <= tl) ? __expf(g0[e] - Mt) : 0.f, w1 = (s0 + 32 + e <= tl) ? __expf(g1[e] - Mt) : 0.f;
                    p0[4 * q4 + e] *= w0; p1[4 * q4 + e] *= w1; dsum += p0[4 * q4 + e] + p1[4 * q4 + e];
                }
            }
            bf16x8 pw[4]; pw[0] = pack8(p0, 0); pw[1] = pack8(p0, 8); pw[2] = pack8(p1, 0); pw[3] = pack8(p1, 8);
#pragma unroll
            for (int b = 0; b < 4; ++b)
#pragma unroll
                for (int ks = 0; ks < 4; ++ks) { const bf16x8 vf = tr_frag(Vb + (dvh * 4 + b) * 4096 + ks * 1024, lane); oT[b] = __builtin_amdgcn_mfma_f32_32x32x16_bf16(vf, pw[ks], oT[b], 0, 0, 0); }
        }
        __syncthreads();
    }
    const float den = swap32_sum(dsum) + den_inter;
    const float inv = 1.f / fmaxf(fabsf(den), __expf(-(bt + Mt)));
    float s1 = 0.f, s2 = 0.f;
#pragma unroll
    for (int b = 0; b < 4; ++b)
#pragma unroll
        for (int r = 0; r < 16; ++r) { oT[b][r] *= inv; s1 += oT[b][r]; s2 += oT[b][r] * oT[b][r]; }
    s1 = swap32_sum(s1); s2 = swap32_sum(s2);
    LAS float* LN = (LAS float*)(lds + ML_LN);
    if (hi == 0) { LN[(dvh * 128 + rg * 32 + r32) * 2] = s1; LN[(dvh * 128 + rg * 32 + r32) * 2 + 1] = s2; }
    __syncthreads();
    { const int ot = ((dvh ^ 1) * 128 + rg * 32 + r32) * 2; s1 += LN[ot]; s2 += LN[ot + 1]; }
    const float mu = s1 * (1.f / 256.f), rstd = rsqrtf(fmaxf(s2 * (1.f / 256.f) - mu * mu, 0.f) + EPS);
    const size_t grow = (size_t)(t0 + tl) * 1024 + head * 256;
#pragma unroll
    for (int b = 0; b < 4; ++b)
#pragma unroll
        for (int g = 0; g < 4; ++g) {
            const int dv = dvh * 128 + b * 32 + 8 * g + 4 * hi;
            const f32x4 gh = *(const f32x4*)(ghn + head * 256 + dv), sk = *(const f32x4*)(skip + head * 256 + dv);
            const u32x2 xx = *(const u32x2*)(XC + grow + dv), zz = *(const u32x2*)(Z + grow + dv);
            const float x0 = bflo(xx.x), x1 = bfhi(xx.x), x2 = bflo(xx.y), x3 = bfhi(xx.y);
            const float v0 = ((oT[b][4 * g] - mu) * rstd * gh[0] + sk[0] * x0) * silu_f(bflo(zz.x));
            const float v1 = ((oT[b][4 * g + 1] - mu) * rstd * gh[1] + sk[1] * x1) * silu_f(bfhi(zz.x));
            const float v2 = ((oT[b][4 * g + 2] - mu) * rstd * gh[2] + sk[2] * x2) * silu_f(bflo(zz.y));
            const float v3 = ((oT[b][4 * g + 3] - mu) * rstd * gh[3] + sk[3] * x3) * silu_f(bfhi(zz.y));
            u32x2 o; o.x = pk2(v0, v1); o.y = pk2(v2, v3);
            *(u32x2*)(OUTM + grow + dv) = o;
        }
    __syncthreads();
}

DEV void norm_phase(const Ctx& c, const bf16_t* mix, const float* ssq16, const float* gpost, float* h, bf16_t* hb, float* rsx) {
    f32x4 g[4];
#pragma unroll
    for (int j = 0; j < 4; ++j) g[j] = *(const f32x4*)(gpost + 4 * c.lane + 256 * j);
    for (int row = c.gw; row < S; row += c.NGW) {
        const float* sp = ssq16 + (size_t)row * 16;
        float ssq = 0.f;
#pragma unroll
        for (int i = 0; i < 16; ++i) ssq += sp[i];
        const float rp = rsqrtf(ssq * (1.f / 1024.f) + EPS);
        float* hr = h + (size_t)row * D; const bf16_t* mr = mix + (size_t)row * D; bf16_t* br = hb + (size_t)row * D;
        f32x4 v[4]; float s2 = 0.f;
#pragma unroll
        for (int j = 0; j < 4; ++j) {
            const u32x2 mm = *(const u32x2*)(mr + 4 * c.lane + 256 * j);
            const f32x4 hv = *(const f32x4*)(hr + 4 * c.lane + 256 * j);
            f32x4 mv = {bflo(mm.x), bfhi(mm.x), bflo(mm.y), bfhi(mm.y)};
            v[j] = hv + mv * g[j] * rp;
            s2 += sq4(v[j]);
        }
        s2 = wave_sum(s2);
#pragma unroll
        for (int j = 0; j < 4; ++j) {
            *(f32x4*)(hr + 4 * c.lane + 256 * j) = v[j];
            u32x2 o; o.x = pk2(v[j][0], v[j][1]); o.y = pk2(v[j][2], v[j][3]);
            *(u32x2*)(br + 4 * c.lane + 256 * j) = o;
        }
        if (c.lane == 0) rsx[row] = rsqrtf(s2 * (1.f / 1024.f) + EPS);
    }
}


#define PROBE 0
#define MULTI_LAUNCH 0
#if PROBE
DEV void probe_err(unsigned* ctl, float err) { if (!(err == err)) err = 1e30f; atomicMax(ctl + 512, __float_as_uint(fabsf(err))); }
DEV void probe_rms(unsigned* ctl, float got, float ref) { float d = got - ref; if (!(d == d)) d = 1e15f; atomicAdd((float*)ctl + 513, d * d); atomicAdd((float*)ctl + 514, ref * ref); }
__global__ void probe_report(const unsigned* ctl, const float* x, float* out) {
    float e = __uint_as_float(ctl[512]);
    int k = e < 0.02f ? 0 : e < 0.05f ? 1 : e < 0.1f ? 2 : e < 0.3f ? 3 : e < 1.f ? 4 : e < 1e29f ? 5 : 6;
    const float den = ((const float*)ctl)[514];
    if (den > 0.f) { e = sqrtf(((const float*)ctl)[513] / den); k = e < 0.003f ? 0 : e < 0.01f ? 1 : e < 0.03f ? 2 : e < 0.1f ? 3 : e < 0.3f ? 4 : e < 1e6f ? 5 : 6; }
    const float f = 1.f + (float)k;
    for (size_t i = blockIdx.x * (size_t)blockDim.x + threadIdx.x; i < (size_t)S * D; i += (size_t)gridDim.x * blockDim.x) out[i] = x[i] * f;
}
__global__ void probe_e1(Args a, int layer) {
    __shared__ float hn[1024]; __shared__ float red[8]; __shared__ float ref[1968];
    const int row = (blockIdx.x * 131 + 7) % S, tid = threadIdx.x, j = layer >> 1;
    const float* x = a.in[0] + (size_t)row * D; const float* g = a.in[3] + layer * 1024; const float* W = a.in[10] + (size_t)j * 1024 * 1968;
    float s2 = 0.f; for (int k = tid; k < 1024; k += 512) s2 += x[k] * x[k];
    s2 = wave_sum(s2); if ((tid & 63) == 0) red[tid >> 6] = s2; __syncthreads();
    float tot = 0.f; for (int i = 0; i < 8; ++i) tot += red[i];
    const float rs = rsqrtf(tot / 1024.f + EPS);
    for (int k = tid; k < 1024; k += 512) hn[k] = x[k] * rs * g[k];
    __syncthreads();
    for (int n = tid; n < 1968; n += 512) { float acc = 0.f; for (int k = 0; k < 1024; ++k) acc += hn[k] * W[(size_t)k * 1968 + n]; ref[n] = acc; }
    __syncthreads();
    const int pos = ((const int*)a.in[2])[row];
    if (tid < 16) { const float inv = powf(10000.f, -(float)tid / 16.f); const float ang = (float)pos * inv; const float c = cosf(ang), sn = sinf(ang);
        const float x1 = ref[384 + tid], x2 = ref[384 + 16 + tid]; ref[384 + tid] = x1 * c - x2 * sn; ref[384 + 16 + tid] = x2 * c + x1 * sn; }
    __syncthreads();
    const bf16_t* proj = (const bf16_t*)(a.ws + WS_R + R_PROJ) + (size_t)row * 2048;
    unsigned* ctl = (unsigned*)(a.ws + WS_CTL);
    CmE1 cm;
    for (int n = tid; n < 1968; n += 512) probe_err(ctl, bf1(proj[cm(n)]) - ref[n]);
    for (int n = 432 + tid; n < 512; n += 512) probe_err(ctl, bf1(proj[n]));
}

__global__ void probe_e2(Args a, int layer) {
    __shared__ float cq[256]; __shared__ float ckv[128]; __shared__ float red[8]; __shared__ float ref[1024];
    const int row = (blockIdx.x * 131 + 7) % S, tid = threadIdx.x, j = layer >> 1;
    const bf16_t* proj = (const bf16_t*)(a.ws + WS_R + R_PROJ) + (size_t)row * 2048;
    unsigned* ctl = (unsigned*)(a.ws + WS_CTL);
    float s2 = 0.f; if (tid < 256) { cq[tid] = bf1(proj[tid]); s2 = cq[tid] * cq[tid]; }
    s2 = wave_sum(s2); if ((tid & 63) == 0) red[tid >> 6] = s2; __syncthreads();
    float tot = 0.f; for (int i = 0; i < 8; ++i) tot += red[i];
    const float rq = rsqrtf(tot / 256.f + EPS);
    __syncthreads();
    s2 = 0.f; if (tid < 128) { ckv[tid] = bf1(proj[256 + tid]); s2 = ckv[tid] * ckv[tid]; }
    s2 = wave_sum(s2); if ((tid & 63) == 0) red[tid >> 6] = s2; __syncthreads();
    tot = 0.f; for (int i = 0; i < 8; ++i) tot += red[i];
    const float rkv = rsqrtf(tot / 128.f + EPS);
    if (tid < 256) cq[tid] *= rq * a.in[11][j * 256 + tid];
    if (tid < 128) ckv[tid] *= rkv * a.in[13][j * 128 + tid];
    __syncthreads();
    const float* Wq = a.in[12] + (size_t)j * 256 * 768; const float* Wkv = a.in[14] + (size_t)j * 128 * 1024;
    const float qs = 0.10206207261596575f * LOG2E;
    for (int n = tid; n < 768; n += 512) { float acc = 0.f; for (int k = 0; k < 256; ++k) acc += cq[k] * Wq[(size_t)k * 768 + n]; ref[n] = acc * qs; }
    __syncthreads();
    const int pos = ((const int*)a.in[2])[row];
    if (tid < 128) { const int hh = tid >> 4, i = tid & 15; const float inv = powf(10000.f, -(float)i / 16.f); const float ang = (float)pos * inv; const float cs = cosf(ang), sn = sinf(ang);
        const float x1 = ref[hh * 96 + 64 + i], x2 = ref[hh * 96 + 80 + i]; ref[hh * 96 + 64 + i] = x1 * cs - x2 * sn; ref[hh * 96 + 80 + i] = x2 * cs + x1 * sn; }
    __syncthreads();
    const bf16_t* Q = (const bf16_t*)(a.ws + WS_R + R_Q) + (size_t)row * 768;
    CmQ cmq; for (int n = tid; n < 768; n += 512) probe_err(ctl, (bf1(Q[cmq(n)]) - ref[n]) * (1.f / 0.147f));
    __syncthreads();
    for (int n = tid; n < 1024; n += 512) { float acc = 0.f; for (int k = 0; k < 128; ++k) acc += ckv[k] * Wkv[(size_t)k * 1024 + n]; ref[n] = acc; }
    __syncthreads();
    const bf16_t* KN = (const bf16_t*)(a.ws + WS_R + R_KN) + (size_t)row * 512; const bf16_t* V = (const bf16_t*)(a.ws + WS_R + R_V) + (size_t)row * 512;
    for (int n = tid; n < 1024; n += 512) { const int hh = n >> 7, r = n & 127; const float got = r < 64 ? bf1(KN[hh * 64 + r]) : bf1(V[hh * 64 + r - 64]); probe_err(ctl, got - ref[n]); }
}
__global__ void __launch_bounds__(256) probe_mla(Args a) {
    __shared__ float q[96]; __shared__ float red[4]; __shared__ float ored[4][64]; __shared__ float lred[4];
    const int si = blockIdx.x >> 3, head = blockIdx.x & 7, tid = threadIdx.x;
    int row = (si * 529 + (si % 3) * 63) % S;
    switch (si) { case 0: row = 0; break; case 1: row = 1; break; case 2: row = 63; break; case 3: row = 64; break; case 4: row = 255; break; case 5: row = 256; break;
                  case 6: row = 257; break; case 7: row = 4095; break; case 8: row = 4096; break; case 9: row = 8191; break; case 10: row = 16383; break; case 11: row = 16128; break; default: break; }
    const bf16_t* Q = (const bf16_t*)(a.ws + WS_R + R_Q); const bf16_t* KN = (const bf16_t*)(a.ws + WS_R + R_KN); const bf16_t* V = (const bf16_t*)(a.ws + WS_R + R_V);
    const bf16_t* PJ = (const bf16_t*)(a.ws + WS_R + R_PROJ); const bf16_t* CAT = (const bf16_t*)(a.ws + WS_R + R_CAT);
    unsigned* ctl = (unsigned*)(a.ws + WS_CTL);
    if (tid < 96) q[tid] = bf1(Q[(size_t)row * 768 + head * 96 + tid]);
    __syncthreads();
    float mx = -INFINITY;
    for (int k = tid; k <= row; k += 256) { float sc = 0.f; for (int d = 0; d < 64; ++d) sc += q[d] * bf1(KN[(size_t)k * 512 + head * 64 + d]);
        for (int d = 0; d < 32; ++d) sc += q[64 + d] * bf1(PJ[(size_t)k * 2048 + PJ_KPE + d]); mx = fmaxf(mx, sc); }
    for (int o = 1; o < 64; o <<= 1) mx = fmaxf(mx, __shfl_xor(mx, o));
    if ((tid & 63) == 0) red[tid >> 6] = mx; __syncthreads();
    mx = fmaxf(fmaxf(red[0], red[1]), fmaxf(red[2], red[3]));
    float l = 0.f; float o[64];
#pragma unroll
    for (int d = 0; d < 64; ++d) o[d] = 0.f;
    for (int k = tid; k <= row; k += 256) { float sc = 0.f; for (int d = 0; d < 64; ++d) sc += q[d] * bf1(KN[(size_t)k * 512 + head * 64 + d]);
        for (int d = 0; d < 32; ++d) sc += q[64 + d] * bf1(PJ[(size_t)k * 2048 + PJ_KPE + d]);
        const float p = exp2f(sc - mx); l += p;
#pragma unroll
        for (int d = 0; d < 64; ++d) o[d] += p * bf1(V[(size_t)k * 512 + head * 64 + d]); }
    l = wave_sum(l);
#pragma unroll
    for (int d = 0; d < 64; ++d) o[d] = wave_sum(o[d]);
    if ((tid & 63) == 0) { lred[tid >> 6] = l;
#pragma unroll
        for (int d = 0; d < 64; ++d) ored[tid >> 6][d] = o[d]; }
    __syncthreads();
    if (tid < 64) { const float lt = lred[0] + lred[1] + lred[2] + lred[3]; const float ov = (ored[0][tid] + ored[1][tid] + ored[2][tid] + ored[3][tid]) / lt;
        probe_err(ctl, bf1(CAT[(size_t)row * 1024 + head * 64 + tid]) - ov); }
}
__global__ void __launch_bounds__(128) probe_gla(Args a, int layer) {
    __shared__ float qa[64], ka[64], aa[64], red[2];
    const int head = blockIdx.x, dv = threadIdx.x, j = layer >> 1;
    const bf16_t* PJ = (const bf16_t*)(a.ws + WS_R + R_PROJ); const bf16_t* CAT = (const bf16_t*)(a.ws + WS_R + R_CAT);
    const float* wg = a.in[15] + (size_t)j * 16 * 256; const float* bg = a.in[16] + j * 256; const float* gn = a.in[17] + j * 128;
    unsigned* ctl = (unsigned*)(a.ws + WS_CTL);
    float st[64];
#pragma unroll
    for (int d = 0; d < 64; ++d) st[d] = 0.f;
    for (int t = 0; t < S; ++t) {
        const bf16_t* pr = PJ + (size_t)t * 2048;
        if (dv < 64) { float x = bg[head * 64 + dv]; for (int jj = 0; jj < 16; ++jj) x += bf1(pr[PJ_GLR + jj]) * wg[jj * 256 + head * 64 + dv];
            aa[dv] = expf(logsigmoid_ref(x) / 16.f); qa[dv] = bf1(pr[PJ_GQ + head * 64 + dv]) * 0.125f; ka[dv] = bf1(pr[PJ_GK + head * 64 + dv]); }
        __syncthreads();
        const float v = bf1(pr[PJ_GV + head * 128 + dv]);
        float o = 0.f;
#pragma unroll
        for (int d = 0; d < 64; ++d) { st[d] = aa[d] * st[d] + ka[d] * v; o += qa[d] * st[d]; }
        const bool sample = (t % 61 == 0) || t >= S - 64 || t < 130;
        if (sample) {
            float s2 = wave_sum(o * o); if ((dv & 63) == 0) red[dv >> 6] = s2; __syncthreads();
            const float rs = rsqrtf((red[0] + red[1]) / 128.f + EPS);
            const float ref = o * rs * gn[dv] * silu_f(bf1(pr[PJ_R + head * 128 + dv]));
            probe_rms(ctl, bf1(CAT[(size_t)t * 1024 + 512 + head * 128 + dv]), ref);
        }
        __syncthreads();
    }
}
__global__ void __launch_bounds__(256) probe_o23(Args a, int layer) {
    __shared__ float xm[1024], xc[1024], qkv[3072], red[4];
    const int tid = threadIdx.x, j = layer >> 1;
    int t = (blockIdx.x * 257 + 3) % S; if (blockIdx.x < 4) t = blockIdx.x; if (blockIdx.x == 4) t = 255; if (blockIdx.x == 5) t = 256; if (blockIdx.x == 6) t = S - 1;
    const bf16_t* XM = (const bf16_t*)(a.ws + WS_R + R_XM); const bf16_t* XC = (const bf16_t*)(a.ws + WS_R + R_XC);
    const bf16_t* MQ = (const bf16_t*)(a.ws + WS_R + R_MQ); const bf16_t* MK = (const bf16_t*)(a.ws + WS_R + R_MK); const bf16_t* MV = (const bf16_t*)(a.ws + WS_R + R_MV);
    const float* gates = (const float*)(a.ws + WS_GATES);
    unsigned* ctl = (unsigned*)(a.ws + WS_CTL);
    const float* cw = a.in[20] + (size_t)j * 4 * 1024; const float* cb = a.in[21] + j * 1024;
    for (int ch = tid; ch < 1024; ch += 256) {
        float y = cb[ch];
        for (int i = 0; i < 4; ++i) { const int tt = t - 3 + i; if (tt >= 0) y += cw[i * 1024 + ch] * bf1(XM[(size_t)tt * 1024 + ch]); }
        const float v = y / (1.f + expf(-y));
        xm[ch] = bf1(XM[(size_t)t * 1024 + ch]); xc[ch] = v;
        probe_rms(ctl, bf1(XC[(size_t)t * 1024 + ch]), v);
    }
    __syncthreads();
    for (int o = tid; o < 3072; o += 256) {
        const int which = o >> 10, hh = (o >> 8) & 3, e = o & 255;
        const float* W = a.in[22 + which] + ((size_t)j * 4 + hh) * 65536;
        const float* src = (which == 2 ? xm : xc) + hh * 256;
        float acc = 0.f; for (int d = 0; d < 256; ++d) acc += src[d] * W[d * 256 + e];
        qkv[hh * 768 + which * 256 + e] = acc;
        const bf16_t* M = which == 0 ? MQ : which == 1 ? MK : MV;
        probe_rms(ctl, bf1(M[(size_t)t * 1024 + hh * 256 + e]), which == 0 ? acc * 0.0625f : acc);
    }
    __syncthreads();
    for (int g = 0; g < 8; ++g) {
        float acc = 0.f; for (int i = tid; i < 3072; i += 256) acc += qkv[i] * a.in[25][(size_t)j * 3072 * 8 + (size_t)i * 8 + g];
        acc = wave_sum(acc); if ((tid & 63) == 0) red[tid >> 6] = acc; __syncthreads();
        if (tid == 0) { const float ref = red[0] + red[1] + red[2] + red[3] + a.in[26][j * 8 + g]; probe_rms(ctl, gates[(size_t)t * 8 + g] * 4.f, ref * 4.f); probe_err(ctl, (gates[(size_t)t * 8 + g] - ref) * 0.2f); }
        __syncthreads();
    }
}
__global__ void __launch_bounds__(512) probe_mlstm(Args a, int layer) {
    __shared__ float q[256], k[256], numred[2][256], red[16], red2[4];
    const int head = blockIdx.x, tid = threadIdx.x, dv = tid & 255, part = tid >> 8, j = layer >> 1;
    const bf16_t* MQ = (const bf16_t*)(a.ws + WS_R + R_MQ); const bf16_t* MK = (const bf16_t*)(a.ws + WS_R + R_MK); const bf16_t* MV = (const bf16_t*)(a.ws + WS_R + R_MV);
    const bf16_t* XC = (const bf16_t*)(a.ws + WS_R + R_XC); const bf16_t* Z = (const bf16_t*)(a.ws + WS_R + R_Z); const bf16_t* OUTM = (const bf16_t*)(a.ws + WS_HB);
    const float* gates = (const float*)(a.ws + WS_GATES); unsigned* ctl = (unsigned*)(a.ws + WS_CTL);
    float C[128];
#pragma unroll
    for (int i = 0; i < 128; ++i) C[i] = 0.f;
    float nn = 0.f, m = 0.f;
    for (int t = 0; t < S; ++t) {
        if (tid < 256) { q[tid] = bf1(MQ[(size_t)t * 1024 + head * 256 + tid]); k[tid] = bf1(MK[(size_t)t * 1024 + head * 256 + tid]); }
        __syncthreads();
        const float v = bf1(MV[(size_t)t * 1024 + head * 256 + dv]);
        const float ii = gates[(size_t)t * 8 + head], lf = logsigmoid_ref(gates[(size_t)t * 8 + 4 + head]);
        const float mnew = fmaxf(lf + m, ii), fd = expf(lf + m - mnew), idd = expf(ii - mnew); m = mnew;
        float num = 0.f;
#pragma unroll
        for (int i = 0; i < 128; ++i) { const int dk = part * 128 + i; C[i] = fd * C[i] + idd * k[dk] * v; num += q[dk] * C[i]; }
        numred[part][dv] = num;
        float dp = 0.f;
        if (tid < 256) { nn = fd * nn + idd * k[tid]; dp = q[tid] * nn; }
        dp = wave_sum(dp); if ((tid & 63) == 0) red[tid >> 6] = dp;
        __syncthreads();
        const bool sample = (t % 53 == 0) || t < 300 || t >= S - 300;
        if (sample) {
            const float den = red[0] + red[1] + red[2] + red[3] + red[4] + red[5] + red[6] + red[7];
            float hv = 0.f, s1 = 0.f, s2 = 0.f;
            if (tid < 256) { hv = (numred[0][dv] + numred[1][dv]) / fmaxf(fabsf(den), expf(-m)); s1 = hv; }
            s1 = wave_sum(s1); if ((tid & 63) == 0 && tid < 256) red2[tid >> 6] = s1; __syncthreads();
            const float mu = (red2[0] + red2[1] + red2[2] + red2[3]) / 256.f; __syncthreads();
            if (tid < 256) s2 = (hv - mu) * (hv - mu);
            s2 = wave_sum(s2); if ((tid & 63) == 0 && tid < 256) red2[tid >> 6] = s2; __syncthreads();
            const float rstd = rsqrtf((red2[0] + red2[1] + red2[2] + red2[3]) / 256.f + EPS);
            if (tid < 256) { const size_t gi = (size_t)t * 1024 + head * 256 + dv;
                const float ref = ((hv - mu) * rstd * a.in[27][j * 1024 + head * 256 + dv] + a.in[28][j * 1024 + head * 256 + dv] * bf1(XC[gi])) * silu_f(bf1(Z[gi]));
                probe_rms(ctl, bf1(OUTM[gi]), ref); }
        }
        __syncthreads();
    }
}
#endif

__global__ void __launch_bounds__(NTHREADS, 2) fwd(Args args) {
    extern __shared__ __attribute__((aligned(16))) unsigned char lds_raw[];
    typedef const Args __attribute__((address_space(4)))* ArgsP;
    ArgsP ap0 = (ArgsP)__builtin_amdgcn_kernarg_segment_ptr();
#define ARGS() ({ ArgsP _q = ap0; asm volatile("" : "+s"(_q)); _q; })
    const int lo = ap0->ph_lo, hi = ap0->ph_hi;
    const int wave0 = __builtin_amdgcn_readfirstlane((int)threadIdx.x >> 6);
    const bool multi = (hi - lo) > 1;
    XcdBarrier bar; bar.bar = (unsigned*)(ap0->ws + WS_CTL) + 4096; bar.x = 0; bar.st = (volatile LAS unsigned*)((LAS unsigned char*)lds_raw + LDS_MISC);
    if (multi) {
        if (threadIdx.x == 0) { bar.st[0] = 0u; bar.st[1] = 0u; bar.st[2] = 0u; bar.st[3] = 0u; }
        __syncthreads();
        bar = xcd_barrier_post(bar.bar, bar.st, (int)threadIdx.x);
    }
#define END_PHASE(k) do { if (multi && (k) + 1 < hi) xcd_barrier(bar, c.tid); } while (0)
#define IN(k) (lo <= (k) && (k) < hi)
#define PHASE_CTX() \
    Ctx c; { int w_ = wave0; asm volatile("" : "+s"(w_)); unsigned z_ = 0u; asm volatile("" : "+s"(z_)); int l_ = (int)__builtin_amdgcn_mbcnt_hi(~0u, __builtin_amdgcn_mbcnt_lo(~0u, z_)); \
      c.lds = (LAS unsigned char*)lds_raw; c.tid = w_ * 64 + l_; c.lane = l_; c.wave = w_; \
      c.G = gridDim.x; const int bx_ = blockIdx.x; c.vcu = (c.G % 8 == 0) ? (bx_ % 8) * (c.G / 8) + bx_ / 8 : bx_; c.gw = c.vcu * NWAVES + c.wave; c.NGW = c.G * NWAVES; } \
    ArgsP ap = ARGS(); unsigned char* ws = ap->ws; float* h = ap->out; \
    float* cosT = (float*)(ws + WS_COS); float* sinT = (float*)(ws + WS_SIN); \
    float* rsx = (float*)(ws + WS_RSX); float* ssq16 = (float*)(ws + WS_SSQ16); \
    float* ssqq = (float*)(ws + WS_SSQQ); float* ssqkv = (float*)(ws + WS_SSQKV); \
    bf16_t* HB = (bf16_t*)(ws + WS_HB); bf16_t* MIX = (bf16_t*)(ws + WS_MIX); \
    unsigned char* R = ws + WS_R; unsigned char* WB = ws + WS_WB; \
    (void)h; (void)cosT; (void)sinT; (void)rsx; (void)ssq16; (void)ssqq; (void)ssqkv; (void)HB; (void)MIX; (void)R; (void)WB;

    if (IN(0)) {
        PHASE_CTX();
        const float* x = ap->in[0]; const int* pos = (const int*)ap->in[2];
        for (int i = c.gw * 64 + c.lane; i < S * 16; i += c.NGW * 64) {
            const int t = i >> 4, f = i & 15;
            const double inv = pow(10000.0, -(double)f / 16.0);
            const double ang = (double)pos[t] * inv;
            cosT[i] = (float)cos(ang); sinT[i] = (float)sin(ang);
        }
        for (int row = c.gw; row < S; row += c.NGW) {
            const float* xr = x + (size_t)row * D; float* hr = h + (size_t)row * D; bf16_t* br = HB + (size_t)row * D;
            float s2 = 0.f;
#pragma unroll
            for (int j = 0; j < 4; ++j) {
                const f32x4 v = *(const f32x4*)(xr + 4 * c.lane + 256 * j);
                s2 += sq4(v);
                *(f32x4*)(hr + 4 * c.lane + 256 * j) = v;
                u32x2 o; o.x = pk2(v[0], v[1]); o.y = pk2(v[2], v[3]);
                *(u32x2*)(br + 4 * c.lane + 256 * j) = o;
            }
            s2 = wave_sum(s2);
            if (c.lane == 0) rsx[row] = rsqrtf(s2 * (1.f / 1024.f) + EPS);
        }
        for (int rr = c.gw; rr < NLAYER * NMEM; rr += c.NGW) {
            const int l = rr >> 8, row = rr & 255;
            const float* mr = ap->in[1] + (size_t)row * D; const float* g = ap->in[7] + l * 1024; bf16_t* br = (bf16_t*)(ws + WS_MEMN) + (size_t)rr * D;
            f32x4 v[4]; float s2 = 0.f;
#pragma unroll
            for (int j = 0; j < 4; ++j) { v[j] = *(const f32x4*)(mr + 4 * c.lane + 256 * j); s2 += sq4(v[j]); }
            s2 = wave_sum(s2);
            const float rs = rsqrtf(s2 * (1.f / 1024.f) + EPS);
#pragma unroll
            for (int j = 0; j < 4; ++j) { const f32x4 gg = *(const f32x4*)(g + 4 * c.lane + 256 * j); const f32x4 o4 = v[j] * gg * rs;
                u32x2 o; o.x = pk2(o4[0], o4[1]); o.y = pk2(o4[2], o4[3]); *(u32x2*)(br + 4 * c.lane + 256 * j) = o; }
        }
        for (int l = 0; l < NLAYER; ++l) {
            prep_job(c, ap->in[31] + (size_t)l * 1024 * 1024, 1024, 1024, 1024, nullptr, 1.f, (bf16_t*)(R + R_XKT) + (size_t)(l * 2 + 0) * 1024 * 1024, 1024, CmId{0});
            prep_job(c, ap->in[32] + (size_t)l * 1024 * 1024, 1024, 1024, 1024, nullptr, 1.f, (bf16_t*)(R + R_XKT) + (size_t)(l * 2 + 1) * 1024 * 1024, 1024, CmId{0});
        }
     END_PHASE(0); }
    if (IN(1)) {
        PHASE_CTX();
        pg8::StaticOrder so; so.init(1, 32, c.G, (int)blockIdx.x);
        ProbKV P{(const bf16_t*)(ws + WS_MEMN), (const bf16_t*)(R + R_XKT), 1024, 1024, 16, (bf16_t*)(ws + WS_KX), (bf16_t*)(ws + WS_VX)};
        pg8::gemm_phase(c.lds, c.tid, so, P);
     END_PHASE(1); }
    for (int l = 0; l < NLAYER; ++l) {
        const int pb = 2 + l * 16;
        const bool even = (l & 1) == 0;
        if (IN(pb + 0)) {
            PHASE_CTX(); int L = l; asm volatile("" : "+s"(L)); const int J = L >> 1; (void)J;
            if (even) {
                prep_job(c, ap->in[10] + (size_t)J * 1024 * 1968, 1968, 1024, 1968, ap->in[3] + L * 1024, 1.f, (bf16_t*)(WB + WB_WIN), 1024, CmE1());
                zero_block(c, (bf16_t*)(WB + WB_WIN) + (size_t)432 * 1024, 80, 1024, 1024);
                prep_job(c, ap->in[12] + (size_t)J * 256 * 768, 768, 256, 768, ap->in[11] + J * 256, 0.10206207261596575f * LOG2E, (bf16_t*)(WB + WB_WUQ), 256, CmQ());
                prep_job(c, ap->in[14] + (size_t)J * 128 * 1024, 1024, 128, 1024, ap->in[13] + J * 128, 1.f, (bf16_t*)(WB + WB_WUKV), 256, CmKV());
                zero_block(c, (bf16_t*)(WB + WB_WUKV) + 128, 1024, 128, 256);
                prep_job(c, ap->in[18] + (size_t)J * 1024 * 1024, 1024, 1024, 1024, nullptr, 1.f, (bf16_t*)(WB + WB_WOUT), 1024, CmId{0});
            }
            if (!even) {
                prep_job(c, ap->in[19] + (size_t)J * 1024 * 2048, 2048, 1024, 2048, ap->in[3] + L * 1024, 1.f, (bf16_t*)(WB + WB_WIN), 1024, CmId{0});
                for (int hh = 0; hh < 4; ++hh) {
                    prep_job(c, ap->in[22] + ((size_t)J * 4 + hh) * 65536, 256, 256, 256, nullptr, 0.0625f, (bf16_t*)(WB + WB_W3) + (size_t)(0 + hh) * 65536, 256, CmId{0});
                    prep_job(c, ap->in[23] + ((size_t)J * 4 + hh) * 65536, 256, 256, 256, nullptr, 1.f, (bf16_t*)(WB + WB_W3) + (size_t)(4 + hh) * 65536, 256, CmId{0});
                    prep_job(c, ap->in[24] + ((size_t)J * 4 + hh) * 65536, 256, 256, 256, nullptr, 1.f, (bf16_t*)(WB + WB_W3) + (size_t)(8 + hh) * 65536, 256, CmId{0});
                }
                prep_job(c, ap->in[29] + (size_t)J * 1024 * 1024, 1024, 1024, 1024, nullptr, 1.f, (bf16_t*)(WB + WB_WOUT), 1024, CmId{0});
                gatefold_job(c, ap->in[22] + (size_t)J * 4 * 65536, ap->in[23] + (size_t)J * 4 * 65536, ap->in[24] + (size_t)J * 4 * 65536, ap->in[25] + (size_t)J * 3072 * 8, (float*)(ws + WS_G12));
            }
            prep_job(c, ap->in[30] + (size_t)L * 1024 * 1024, 1024, 1024, 1024, ap->in[5] + L * 1024, 0.0625f * LOG2E, (bf16_t*)(WB + WB_XQ), 1024, CmId{0});
            prep_job(c, ap->in[33] + (size_t)L * 1024 * 1024, 1024, 1024, 1024, nullptr, 1.f, (bf16_t*)(WB + WB_XO), 1024, CmId{0});
            prep_job(c, ap->in[34] + (size_t)L * 1024 * 4096, 4096, 1024, 4096, ap->in[8] + L * 1024, 1.f, (bf16_t*)(WB + WB_W1), 1024, CmId{0});
            prep_job(c, ap->in[35] + (size_t)L * 4096 * 1024, 1024, 4096, 1024, nullptr, 1.f, (bf16_t*)(WB + WB_W2), 4096, CmId{0});
         END_PHASE(pb + 0); }
        if (even) {
            if (IN(pb + 1)) {
                PHASE_CTX(); int L = l; asm volatile("" : "+s"(L)); const int J = L >> 1; (void)J;
                pg8::StaticOrder so; so.init(S / 256, 8, c.G, (int)blockIdx.x);
                ProbE1 P{HB, (const bf16_t*)(WB + WB_WIN), 1024, 1024, 16, (bf16_t*)(R + R_PROJ), rsx, ssqq, ssqkv, cosT, sinT};
                pg8::gemm_phase(c.lds, c.tid, so, P);
             END_PHASE(pb + 1); }
            if (IN(pb + 2)) {
                PHASE_CTX(); int L = l; asm volatile("" : "+s"(L)); const int J = L >> 1; (void)J;
                pg8::StaticOrder so; so.init(S / 256, 7, c.G, (int)blockIdx.x);
                ProbE2 P{(const bf16_t*)(R + R_PROJ), (const bf16_t*)(WB + WB_WUQ), (const bf16_t*)(WB + WB_WUKV), 2048, 256, 4,
                         (bf16_t*)(R + R_Q), (bf16_t*)(R + R_KN), (bf16_t*)(R + R_V), ssqq, ssqkv, cosT, sinT};
                pg8::gemm_phase(c.lds, c.tid, so, P);
                for (int u = c.vcu; u < 1024; u += c.G)
                    gla_a_unit(c, (const bf16_t*)(R + R_PROJ), ap->in[15] + (size_t)J * 16 * 256, ap->in[16] + J * 256, u >> 2, u & 3, (bf16_t*)(R + R_GST), (float*)(ws + WS_GDEC));
             END_PHASE(pb + 2); }
            if (IN(pb + 3)) {
                PHASE_CTX(); int L = l; asm volatile("" : "+s"(L)); const int J = L >> 1; (void)J;
                const bf16_t* Q = (const bf16_t*)(R + R_Q); const bf16_t* KN = (const bf16_t*)(R + R_KN); const bf16_t* V = (const bf16_t*)(R + R_V);
                const bf16_t* PJ = (const bf16_t*)(R + R_PROJ); bf16_t* CAT = (bf16_t*)(R + R_CAT);
                gla_scan(c, (bf16_t*)(R + R_GST), (const float*)(ws + WS_GDEC));
                for (int u = c.vcu; u < 256; u += c.G) {
                    const int head = u >> 5, sidx = u & 31;
                    for (int half = 0; half < 2; ++half) {
                        const int qb = half ? 63 - sidx : sidx;
                        const size_t r0 = (size_t)qb * 256 + c.wave * 32;
                        flash_unit<8, 4, 2, 2, true>(c, Q + r0 * 768 + head * 96, 768, KN + head * 64, 512, PJ + PJ_KPE, 2048, V + head * 64, 512,
                                                     CAT + r0 * 1024 + head * 64, 1024, 4 * (qb + 1), 0, c.wave * 32, 4 * qb);
                    }
                }
             END_PHASE(pb + 3); }
            if (IN(pb + 4)) {
                PHASE_CTX(); int L = l; asm volatile("" : "+s"(L)); const int J = L >> 1; (void)J;
                for (int u = c.vcu; u < 1024; u += c.G)
                    gla_c_unit(c, (const bf16_t*)(R + R_PROJ), ap->in[15] + (size_t)J * 16 * 256, ap->in[16] + J * 256, ap->in[17] + J * 128, u >> 2, u & 3, (const bf16_t*)(R + R_GST), (bf16_t*)(R + R_CAT));
             END_PHASE(pb + 4); }
            if (IN(pb + 5)) {
                PHASE_CTX(); int L = l; asm volatile("" : "+s"(L)); const int J = L >> 1; (void)J;
                pg8::StaticOrder so; so.init(S / 256, 4, c.G, (int)blockIdx.x);
                ProbPlain P{(const bf16_t*)(R + R_CAT), (const bf16_t*)(WB + WB_WOUT), 1024, 1024, 16, MIX, 1024, nullptr, 1 << 30, nullptr, 0, ssq16, 16};
                pg8::gemm_phase(c.lds, c.tid, so, P);
             END_PHASE(pb + 5); }
        }
        if (!even) {
            if (IN(pb + 1)) {
                PHASE_CTX(); int L = l; asm volatile("" : "+s"(L)); const int J = L >> 1; (void)J;
                pg8::StaticOrder so; so.init(S / 256, 8, c.G, (int)blockIdx.x);
                ProbPlain P{HB, (const bf16_t*)(WB + WB_WIN), 1024, 1024, 16, (bf16_t*)(R + R_XM), 1024, (bf16_t*)(R + R_Z), 4, rsx, 0, nullptr, 0};
                pg8::gemm_phase(c.lds, c.tid, so, P);
             END_PHASE(pb + 1); }
            if (IN(pb + 2)) {
                PHASE_CTX(); int L = l; asm volatile("" : "+s"(L)); const int J = L >> 1; (void)J;
                conv_phase(c, (const bf16_t*)(R + R_XM), ap->in[20] + (size_t)J * 4 * 1024, ap->in[21] + J * 1024, (const float*)(ws + WS_G12), ap->in[26] + J * 8,
                           (bf16_t*)(R + R_XC), (float*)(ws + WS_GATES));
             END_PHASE(pb + 2); }
            if (IN(pb + 3)) {
                PHASE_CTX(); int L = l; asm volatile("" : "+s"(L)); const int J = L >> 1; (void)J;
                pg8::StaticOrder so; so.init(S / 256, 12, c.G, (int)blockIdx.x);
                ProbO3 P{(const bf16_t*)(R + R_XC), (const bf16_t*)(R + R_XM), (const bf16_t*)(WB + WB_W3), 1024, 256, 4, (bf16_t*)(R + R_MQ), (bf16_t*)(R + R_MK), (bf16_t*)(R + R_MV)};
                pg8::gemm_phase(c.lds, c.tid, so, P);
             END_PHASE(pb + 3); }
            if (IN(pb + 4)) {
                PHASE_CTX(); int L = l; asm volatile("" : "+s"(L)); const int J = L >> 1; (void)J;
                for (int u = c.vcu; u < 63 * 4; u += c.G)
                    mlstm_a_unit(c, (const float*)(ws + WS_GATES), (const bf16_t*)(R + R_MK), (const bf16_t*)(R + R_MV), u >> 2, u & 3, (bf16_t*)(R + R_XM), (float*)(ws + WS_MST));
             END_PHASE(pb + 4); }
            if (IN(pb + 5)) { PHASE_CTX(); int L = l; asm volatile("" : "+s"(L)); const int J = L >> 1; (void)J; mlstm_scan(c, (bf16_t*)(R + R_XM), (float*)(ws + WS_MST));  END_PHASE(pb + 5); }
            if (IN(pb + 6)) {
                PHASE_CTX(); int L = l; asm volatile("" : "+s"(L)); const int J = L >> 1; (void)J;
                for (int u = c.vcu; u < 512; u += c.G)
                    mlstm_c_unit(c, (const float*)(ws + WS_GATES), (const bf16_t*)(R + R_MQ), (const bf16_t*)(R + R_MK), (const bf16_t*)(R + R_MV), (const bf16_t*)(R + R_XM), (const float*)(ws + WS_MST),
                                 (const bf16_t*)(R + R_XC), (const bf16_t*)(R + R_Z), ap->in[27] + J * 1024, ap->in[28] + J * 1024, HB, u >> 3, (u >> 1) & 3, u & 1);
             END_PHASE(pb + 6); }
            if (IN(pb + 7)) {
                PHASE_CTX(); int L = l; asm volatile("" : "+s"(L)); const int J = L >> 1; (void)J;
                pg8::StaticOrder so; so.init(S / 256, 4, c.G, (int)blockIdx.x);
                ProbPlain P{HB, (const bf16_t*)(WB + WB_WOUT), 1024, 1024, 16, MIX, 1024, nullptr, 1 << 30, nullptr, 0, ssq16, 16};
                pg8::gemm_phase(c.lds, c.tid, so, P);
             END_PHASE(pb + 7); }
        }
        if (IN(pb + 8)) { PHASE_CTX(); int L = l; asm volatile("" : "+s"(L)); const int J = L >> 1; (void)J; norm_phase(c, MIX, ssq16, ap->in[4] + L * 1024, h, HB, rsx);  END_PHASE(pb + 8); }
        if (IN(pb + 9)) {
            PHASE_CTX(); int L = l; asm volatile("" : "+s"(L)); const int J = L >> 1; (void)J;
            pg8::StaticOrder so; so.init(S / 256, 4, c.G, (int)blockIdx.x);
            ProbPlain P{HB, (const bf16_t*)(WB + WB_XQ), 1024, 1024, 16, (bf16_t*)(R + R_XQ), 1024, nullptr, 1 << 30, rsx, 0, nullptr, 0};
            pg8::gemm_phase(c.lds, c.tid, so, P);
         END_PHASE(pb + 9); }
        if (IN(pb + 10)) {
            PHASE_CTX(); int L = l; asm volatile("" : "+s"(L)); const int J = L >> 1; (void)J;
            const bf16_t* XQ = (const bf16_t*)(R + R_XQ); bf16_t* XO = (bf16_t*)(R + R_XO);
            const bf16_t* KX = (const bf16_t*)(ws + WS_KX) + (size_t)L * 256 * 1024; const bf16_t* VX = (const bf16_t*)(ws + WS_VX) + (size_t)L * 256 * 1024;
            const int rg = c.wave >> 1, dvh = c.wave & 1;
            for (int u = c.vcu; u < 512; u += c.G) {
                const int pp = u >> 2, head = u & 3;
                const size_t r0 = (size_t)pp * 128 + rg * 32;
                flash_unit<32, 0, 8, 4, false>(c, XQ + r0 * 1024 + head * 256, 1024, KX + head * 256, 1024, KX, 1024, VX + head * 256, 1024,
                                               XO + r0 * 1024 + head * 256 + dvh * 128, 1024, 4, dvh * 4, 0, 0);
            }
         END_PHASE(pb + 10); }
        if (IN(pb + 11)) {
            PHASE_CTX(); int L = l; asm volatile("" : "+s"(L)); const int J = L >> 1; (void)J;
            pg8::StaticOrder so; so.init(S / 256, 4, c.G, (int)blockIdx.x);
            ProbPlain P{(const bf16_t*)(R + R_XO), (const bf16_t*)(WB + WB_XO), 1024, 1024, 16, MIX, 1024, nullptr, 1 << 30, nullptr, 0, ssq16, 16};
            pg8::gemm_phase(c.lds, c.tid, so, P);
         END_PHASE(pb + 11); }
        if (IN(pb + 12)) { PHASE_CTX(); int L = l; asm volatile("" : "+s"(L)); const int J = L >> 1; (void)J; norm_phase(c, MIX, ssq16, ap->in[6] + L * 1024, h, HB, rsx);  END_PHASE(pb + 12); }
        if (IN(pb + 13)) {
            PHASE_CTX(); int L = l; asm volatile("" : "+s"(L)); const int J = L >> 1; (void)J;
            pg8::StaticOrder so; so.init(S / 256, 16, c.G, (int)blockIdx.x);
            ProbPlain P{HB, (const bf16_t*)(WB + WB_W1), 1024, 1024, 16, (bf16_t*)(R + R_U), 4096, nullptr, 1 << 30, rsx, 1, nullptr, 0};
            pg8::gemm_phase(c.lds, c.tid, so, P);
         END_PHASE(pb + 13); }
        if (IN(pb + 14)) {
            PHASE_CTX(); int L = l; asm volatile("" : "+s"(L)); const int J = L >> 1; (void)J;
            pg8::StaticOrder so; so.init(S / 256, 4, c.G, (int)blockIdx.x);
            ProbPlain P{(const bf16_t*)(R + R_U), (const bf16_t*)(WB + WB_W2), 4096, 4096, 64, MIX, 1024, nullptr, 1 << 30, nullptr, 0, ssq16, 16};
            pg8::gemm_phase(c.lds, c.tid, so, P);
         END_PHASE(pb + 14); }
        if (IN(pb + 15)) { PHASE_CTX(); int L = l; asm volatile("" : "+s"(L)); const int J = L >> 1; (void)J; norm_phase(c, MIX, ssq16, ap->in[9] + L * 1024, h, HB, rsx);  END_PHASE(pb + 15); }
    }
#undef IN
}

extern "C" void kernel_launch(void* const* d_in, const int* in_sizes, int n_in, void* d_out, int out_size, void* d_ws, size_t ws_size, hipStream_t stream) {
    static int grid = 0;
    if (grid == 0) {
        if (n_in != 36 || out_size != S * D || ws_size < WS_END) { fprintf(stderr, "kernel_launch: unexpected shapes (n_in %d, out %d, ws %zu < %zu)\n", n_in, out_size, ws_size, (size_t)WS_END); grid = -1; return; }
        int dev = 0, cus = 0, per_cu = 0;
        hipGetDevice(&dev); hipDeviceGetAttribute(&cus, hipDeviceAttributeMultiprocessorCount, dev);
        if (hipFuncSetAttribute((const void*)fwd, hipFuncAttributeMaxDynamicSharedMemorySize, LDS_BYTES) != hipSuccess) { fprintf(stderr, "kernel_launch: hipFuncSetAttribute failed\n"); grid = -1; return; }
        hipOccupancyMaxActiveBlocksPerMultiprocessor(&per_cu, (const void*)fwd, NTHREADS, LDS_BYTES);
        (void)hipGetLastError();
        grid = cus > 0 ? cus : 256;
    }
    if (grid < 0) return;
    hipMemsetAsync((char*)d_ws + WS_CTL, 0, 1 * MiB, stream);
    Args a{};
    for (int i = 0; i < 36; ++i) a.in[i] = (const float*)d_in[i];
    a.out = (float*)d_out; a.ws = (unsigned char*)d_ws;
    const int PH_END = 2 + 16 * NLAYER;
#if MULTI_LAUNCH
    for (int p = 0; p < PH_END; ++p) {
        a.ph_lo = p; a.ph_hi = p + 1;
        hipLaunchKernelGGL(fwd, dim3(grid), dim3(NTHREADS), LDS_BYTES, stream, a);
    }
#else
    a.ph_lo = 0; a.ph_hi = PH_END;
    hipLaunchKernelGGL(fwd, dim3(grid), dim3(NTHREADS), LDS_BYTES, stream, a);
#endif
#if PROBE
    hipLaunchKernelGGL(probe_mlstm, dim3(4), dim3(512), 0, stream, a, 1);
    hipLaunchKernelGGL(probe_report, dim3(1024), dim3(256), 0, stream, (const unsigned*)d_ws, (const float*)d_in[0], (float*)d_out);
#endif
}
```

```cpp
#include <hip/hip_runtime.h>
#include <cstdio>
#include <cstdint>

#define LAS __attribute__((address_space(3)))
#define GAS __attribute__((address_space(1)))
#define DEV __device__ __forceinline__
typedef unsigned short bf16_t;
typedef short bf16x8 __attribute__((ext_vector_type(8)));
typedef short s16x4 __attribute__((ext_vector_type(4)));
typedef float f32x4 __attribute__((ext_vector_type(4)));
typedef float f32x16 __attribute__((ext_vector_type(16)));
typedef float f32x2 __attribute__((ext_vector_type(2)));
typedef unsigned u32x4 __attribute__((ext_vector_type(4)));
typedef unsigned u32x2 __attribute__((ext_vector_type(2)));
typedef __bf16 bf16x2_t __attribute__((ext_vector_type(2)));
typedef short v4i16_t __attribute__((ext_vector_type(4)));

constexpr int S = 16384, D = 1024, NLAYER = 4, NMEM = 256, DFF = 4096;
constexpr float EPS = 1e-6f;
constexpr float LOG2E = 1.4426950408889634f;
constexpr int NTHREADS = 512, NWAVES = 8;

constexpr size_t MiB = 1u << 20, KiB = 1024;
constexpr size_t WS_CTL = 0;
constexpr size_t WS_COS = 1 * MiB;
constexpr size_t WS_SIN = 2 * MiB;
constexpr size_t WS_RSX = 3 * MiB;
constexpr size_t WS_SSQ16 = 4 * MiB;
constexpr size_t WS_SSQQ = 5 * MiB;
constexpr size_t WS_SSQKV = 5 * MiB + 256 * KiB;
constexpr size_t WS_GATES = 5 * MiB + 512 * KiB;
constexpr size_t WS_G12 = 6 * MiB;
constexpr size_t WS_GDEC = 6 * MiB + 128 * KiB;
constexpr size_t WS_MST = 6 * MiB + 512 * KiB;
constexpr size_t WS_KX = 8 * MiB;
constexpr size_t WS_VX = 10 * MiB;
constexpr size_t WS_MEMN = 12 * MiB;
constexpr size_t WS_WB = 16 * MiB;
constexpr size_t WS_HB = 44 * MiB;
constexpr size_t WS_MIX = 76 * MiB;
constexpr size_t WS_R = 108 * MiB;
constexpr size_t WS_END = 300 * MiB;
constexpr size_t WB_WIN = 0;
constexpr size_t WB_WUQ = 4 * MiB;
constexpr size_t WB_WUKV = 4 * MiB + 512 * KiB;
constexpr size_t WB_W3 = 4 * MiB;
constexpr size_t WB_WOUT = 6 * MiB;
constexpr size_t WB_XQ = 8 * MiB;
constexpr size_t WB_XO = 10 * MiB;
constexpr size_t WB_W1 = 12 * MiB;
constexpr size_t WB_W2 = 20 * MiB;
constexpr size_t R_PROJ = 0;
constexpr size_t R_Q = 64 * MiB;
constexpr size_t R_KN = 88 * MiB;
constexpr size_t R_V = 104 * MiB;
constexpr size_t R_CAT = 120 * MiB;
constexpr size_t R_GST = 152 * MiB;
constexpr size_t R_XQ = 0, R_XO = 32 * MiB;
constexpr size_t R_U = 0;
constexpr size_t R_XM = 0, R_Z = 32 * MiB, R_XC = 64 * MiB, R_MQ = 96 * MiB, R_MK = 128 * MiB, R_MV = 160 * MiB;
constexpr size_t R_XKT = 0;

constexpr int PJ_CQ = 0, PJ_CKV = 256, PJ_KPE = 384, PJ_GLR = 416, PJ_GQ = 512, PJ_GK = 768, PJ_GV = 1024, PJ_R = 1536;

constexpr int LDS_BYTES = 160 * 1024;
constexpr int LDS_MISC = 156 * 1024;

DEV unsigned pk2(float lo, float hi) { f32x2 v = {lo, hi}; bf16x2_t b = __builtin_convertvector(v, bf16x2_t); return __builtin_bit_cast(unsigned, b); }
DEV float bflo(unsigned u) { return __uint_as_float(u << 16); }
DEV float bfhi(unsigned u) { return __uint_as_float(u & 0xffff0000u); }
DEV float bf1(bf16_t b) { return __uint_as_float(((unsigned)b) << 16); }
DEV bf16_t f2bf(float f) { return (bf16_t)(pk2(f, 0.f) & 0xffffu); }
DEV float wave_sum(float v) {
#pragma unroll
    for (int o = 1; o < 64; o <<= 1) v += __shfl_xor(v, o);
    return v;
}
DEV int crow(int r, int hi) { return (r & 3) + 8 * (r >> 2) + 4 * hi; }
DEV float swap32_max(float m) { auto rr = __builtin_amdgcn_permlane32_swap(__float_as_uint(m), __float_as_uint(m), false, false); return fmaxf(__uint_as_float(rr[0]), __uint_as_float(rr[1])); }
DEV float swap32_sum(float m) { auto rr = __builtin_amdgcn_permlane32_swap(__float_as_uint(m), __float_as_uint(m), false, false); return __uint_as_float(rr[0]) + __uint_as_float(rr[1]); }
DEV int rope_perm(int l) { return 8 * ((l >> 2) & 3) + 4 * (l >> 4) + (l & 3); }
DEV float silu_f(float x) { return x / (1.f + __expf(-x)); }
DEV float logsigmoid_f(float x) { return fminf(x, 0.f) - __logf(1.f + __expf(-fabsf(x))); }
DEV float logsigmoid_ref(float x) { return fminf(x, 0.f) - log1pf(expf(-fabsf(x))); }
#define LDS_WAIT() asm volatile("s_waitcnt lgkmcnt(0)" ::: "memory")

struct Args {
    const float* in[36];
    float* out;
    unsigned char* ws;
    int ph_lo, ph_hi;
};

struct Ctx {
    LAS unsigned char* lds;
    int tid, lane, wave, G, vcu, gw, NGW;
};


#define XB_TMO      128
#define XB_XCNT(j)  (256  + 64 * (j))
#define XB_XSUB(j)  (1280 + 64 * (j))
#define XB_XGEN(j)  (2304 + 64 * (j))
#define XB_TOP      3328
#define XB_TOPGEN   3392
#define XCD_BAR_WORDS 3456
#define XB_SPIN_CAP (1u << 18)
DEV unsigned xb_ld(unsigned* p)              { return __hip_atomic_load(p, __ATOMIC_RELAXED, __HIP_MEMORY_SCOPE_AGENT); }
DEV unsigned xb_add(unsigned* p, unsigned v) { return __hip_atomic_fetch_add(p, v, __ATOMIC_RELAXED, __HIP_MEMORY_SCOPE_AGENT); }
DEV unsigned xb_xcc_id() { return (unsigned)__builtin_amdgcn_s_getreg((3 << 11) | 20) & 0xFu; }
#define XB_SPIN(cond, bar) do { unsigned _sp = 0; while (cond) { __builtin_amdgcn_s_sleep(1); \
    if ((++_sp & 255u) == 0u) { if (xb_ld(&(bar)[XB_TMO])) break; if (_sp > XB_SPIN_CAP) { atomicAdd(&(bar)[XB_TMO], 1u); break; } } } } while (0)
struct XcdBarrier { unsigned* bar; unsigned x; volatile LAS unsigned* st; };
DEV XcdBarrier xcd_barrier_post(unsigned* bar, volatile LAS unsigned* st, int tid) {
    XcdBarrier b; b.bar = bar; b.x = xb_xcc_id(); b.st = st;
    if (tid == 0) (void)xb_add(&bar[XB_XCNT(b.x)], 1u);
    return b;
}
DEV void xcd_barrier_complete(unsigned* bar, unsigned x, unsigned& nloc, unsigned& nx) {
    const unsigned G = gridDim.x * gridDim.y * gridDim.z;
    unsigned sum, cnt, mine, sp = 0u;
    for (;;) {
        sum = 0u; cnt = 0u; mine = 0u;
#pragma unroll
        for (unsigned j = 0; j < 16; ++j) { const unsigned c = xb_ld(&bar[XB_XCNT(j)]); sum += c; cnt += (c > 0u) ? 1u : 0u; mine = (j == x) ? c : mine; }
        if (sum == G) break;
        __builtin_amdgcn_s_sleep(1);
        if ((++sp & 255u) == 0u) { if (xb_ld(&bar[XB_TMO])) break; if (sp > XB_SPIN_CAP) { atomicAdd(&bar[XB_TMO], 1u); break; } }
    }
    nloc = mine > 0u ? mine : 1u; nx = cnt > 0u ? cnt : 1u;
}
DEV void xcd_barrier(const XcdBarrier& b, int tid) {
    asm volatile("s_waitcnt vmcnt(0)" ::: "memory");
    __syncthreads();
    if (tid == 0) {
        unsigned* bar = b.bar;
        __builtin_amdgcn_s_waitcnt(0);
        unsigned nloc = b.st[0], nx = b.st[1];
        if (nloc == 0u) { xcd_barrier_complete(bar, b.x, nloc, nx); b.st[0] = nloc; b.st[1] = nx; }
        const unsigned old = xb_add(&bar[XB_XSUB(b.x)], 1u);
        const unsigned gen = old / nloc;
        if (old + 1u == (gen + 1u) * nloc) {
            __builtin_amdgcn_fence(__ATOMIC_RELEASE, "agent");
            asm volatile("s_waitcnt vmcnt(0)" ::: "memory");
            const unsigned og = xb_add(&bar[XB_TOP], 1u);
            const unsigned tg = og / nx;
            if (og + 1u == (tg + 1u) * nx) xb_add(&bar[XB_TOPGEN], 1u);
            else XB_SPIN(xb_ld(&bar[XB_TOPGEN]) == tg, bar);
            __builtin_amdgcn_fence(__ATOMIC_ACQUIRE, "agent");
            xb_add(&bar[XB_XGEN(b.x)], 1u);
            asm volatile("s_waitcnt vmcnt(0)" ::: "memory");
        } else {
            XB_SPIN(xb_ld(&bar[XB_XGEN(b.x)]) == gen, bar);
            __builtin_amdgcn_fence(__ATOMIC_ACQUIRE, "agent");
            asm volatile("s_waitcnt vmcnt(0)" ::: "memory");
        }
    }
    __syncthreads();
}

struct CmId { int off; DEV int operator()(int n) const { return n + off; } };
struct CmE1 { DEV int operator()(int n) const {
    if (n < 384) return n;
    if (n < 416) return PJ_KPE + rope_perm(n - 384);
    if (n < 672) return PJ_GQ + (n - 416);
    if (n < 928) return PJ_GK + (n - 672);
    if (n < 1440) return PJ_GV + (n - 928);
    if (n < 1456) return PJ_GLR + (n - 1440);
    return PJ_R + (n - 1456); } };
struct CmQ { DEV int operator()(int n) const { const int h = n / 96, r = n - h * 96; return r < 64 ? n : h * 96 + 64 + rope_perm(r - 64); } };
struct CmKV { DEV int operator()(int n) const { const int h = n >> 7, r = n & 127; return r < 64 ? h * 64 + r : 512 + h * 64 + (r - 64); } };

template <class CM>
DEV void prep_job(const Ctx& c, const float* W, int ldw, int Ksrc, int Nsrc, const float* gk, float scale, bf16_t* WT, int ldt, const CM cm) {
    LAS float* scr = (LAS float*)(c.lds + c.wave * 8704);
    const int nblk = (Nsrc + 31) / 32, nitems = (Ksrc / 64) * nblk, lane = c.lane;
    for (int it = c.gw; it < nitems; it += c.NGW) {
        const int kb = it / nblk, nb = it - kb * nblk, k0 = kb * 64, n0 = nb * 32;
        const int nr = n0 + (lane & 31);
#pragma unroll 8
        for (int i = 0; i < 32; ++i) {
            const int kk = 2 * i + (lane >> 5);
            float v = (nr < Nsrc) ? W[(size_t)(k0 + kk) * ldw + nr] : 0.f;
            if (gk) v *= gk[k0 + kk];
            scr[kk * 33 + (lane & 31)] = v * scale;
        }
        LDS_WAIT(); asm volatile("" ::: "memory");
        const int cc = lane & 7;
#pragma unroll
        for (int j = 0; j < 4; ++j) {
            const int nl = (lane >> 3) + 8 * j, n = n0 + nl;
            if (n < Nsrc) {
                const int dr = cm(n);
                const LAS float* s = scr + (8 * cc) * 33 + nl;
                u32x4 o; o.x = pk2(s[0], s[33]); o.y = pk2(s[66], s[99]); o.z = pk2(s[132], s[165]); o.w = pk2(s[198], s[231]);
                *(u32x4*)(WT + (size_t)dr * ldt + k0 + 8 * cc) = o;
            }
        }
        LDS_WAIT(); asm volatile("" ::: "memory");
    }
}
DEV void zero_block(const Ctx& c, bf16_t* p, int rows, int cols, int ld) {
    const int cpr = cols / 8, n = rows * cpr;
    unsigned z = 0u; asm volatile("" : "+v"(z));
    for (int i = c.gw * 64 + c.lane; i < n; i += c.NGW * 64) { const int r = i / cpr, cc = i - r * cpr; *(u32x4*)(p + (size_t)r * ld + cc * 8) = (u32x4){z, z, z, z}; }
}


DEV void gatefold_job(const Ctx& c, const float* wq, const float* wk, const float* wv, const float* Wg, float* G12) {
    for (int i = c.gw * 64 + c.lane; i < 16 * 1024; i += c.NGW * 64) {
        const int g16 = i >> 10, ch = i & 1023, hh = ch >> 8, d = ch & 255, g = g16 & 7;
        float acc = 0.f;
        if (g16 < 8) { const float* a = wq + ((size_t)hh * 256 + d) * 256; const float* b = wk + ((size_t)hh * 256 + d) * 256;
            for (int e = 0; e < 256; ++e) acc += a[e] * Wg[(size_t)(hh * 768 + e) * 8 + g] + b[e] * Wg[(size_t)(hh * 768 + 256 + e) * 8 + g]; }
        else { const float* a = wv + ((size_t)hh * 256 + d) * 256;
            for (int e = 0; e < 256; ++e) acc += a[e] * Wg[(size_t)(hh * 768 + 512 + e) * 8 + g]; }
        G12[i] = acc;
    }
}

struct PJ { const float* W; const float* gk; bf16_t* WT; int ldw, Ksrc, Nsrc, ldt, cm; float scale; };
DEV int pj_items(const PJ& j) { return (j.Ksrc / 64) * ((j.Nsrc + 31) / 32); }
DEV int cm_apply(int cm, int n) {
    switch (cm) { case 1: return CmE1()(n); case 2: return CmQ()(n); case 3: return CmKV()(n); default: return n; }
}
DEV void prep_item(const Ctx& c, const PJ& j, int it) {
    LAS float* scr = (LAS float*)(c.lds + c.wave * 8704);
    const int lane = c.lane, nblk = (j.Nsrc + 31) / 32;
    const int kb = it / nblk, nb = it - kb * nblk, k0 = kb * 64, n0 = nb * 32;
    const int nr = n0 + (lane & 31);
    float v[32];
#pragma unroll
    for (int i = 0; i < 32; ++i) { const int kk = 2 * i + (lane >> 5); v[i] = (nr < j.Nsrc) ? j.W[(size_t)(k0 + kk) * j.ldw + nr] : 0.f; }
    if (j.gk) {
#pragma unroll
        for (int i = 0; i < 32; ++i) v[i] *= j.gk[k0 + 2 * i + (lane >> 5)];
    }
#pragma unroll
    for (int i = 0; i < 32; ++i) scr[(2 * i + (lane >> 5)) * 33 + (lane & 31)] = v[i] * j.scale;
    LDS_WAIT(); asm volatile("" ::: "memory");
    const int cc = lane & 7;
#pragma unroll
    for (int jj = 0; jj < 4; ++jj) {
        const int nl = (lane >> 3) + 8 * jj, n = n0 + nl;
        if (n < j.Nsrc) {
            const int dr = cm_apply(j.cm, n);
            const LAS float* s = scr + (8 * cc) * 33 + nl;
            u32x4 o; o.x = pk2(s[0], s[33]); o.y = pk2(s[66], s[99]); o.z = pk2(s[132], s[165]); o.w = pk2(s[198], s[231]);
            *(u32x4*)(j.WT + (size_t)dr * j.ldt + k0 + 8 * cc) = o;
        }
    }
    LDS_WAIT(); asm volatile("" ::: "memory");
}
template <class ArgsPT>
DEV PJ layer_job(ArgsPT ap, unsigned char* WB, int L, bool even, int jx) {
    const int J = L >> 1; PJ j; j.gk = nullptr; j.scale = 1.f; j.cm = 0;
    if (jx == 0) { j.W = ap->in[34] + (size_t)L * 1024 * 4096; j.gk = ap->in[8] + L * 1024; j.WT = (bf16_t*)(WB + WB_W1); j.ldw = 4096; j.Ksrc = 1024; j.Nsrc = 4096; j.ldt = 1024; return j; }
    if (jx == 1) { j.W = ap->in[35] + (size_t)L * 4096 * 1024; j.WT = (bf16_t*)(WB + WB_W2); j.ldw = 1024; j.Ksrc = 4096; j.Nsrc = 1024; j.ldt = 4096; return j; }
    if (jx == 2) { j.W = ap->in[30] + (size_t)L * 1024 * 1024; j.gk = ap->in[5] + L * 1024; j.scale = 0.0625f * LOG2E; j.WT = (bf16_t*)(WB + WB_XQ); j.ldw = 1024; j.Ksrc = 1024; j.Nsrc = 1024; j.ldt = 1024; return j; }
    if (jx == 3) { j.W = ap->in[33] + (size_t)L * 1024 * 1024; j.WT = (bf16_t*)(WB + WB_XO); j.ldw = 1024; j.Ksrc = 1024; j.Nsrc = 1024; j.ldt = 1024; return j; }
    if (even) {
        if (jx == 4) { j.W = ap->in[10] + (size_t)J * 1024 * 1968; j.gk = ap->in[3] + L * 1024; j.WT = (bf16_t*)(WB + WB_WIN); j.ldw = 1968; j.Ksrc = 1024; j.Nsrc = 1968; j.ldt = 1024; j.cm = 1; return j; }
        if (jx == 5) { j.W = ap->in[18] + (size_t)J * 1024 * 1024; j.WT = (bf16_t*)(WB + WB_WOUT); j.ldw = 1024; j.Ksrc = 1024; j.Nsrc = 1024; j.ldt = 1024; return j; }
        if (jx == 6) { j.W = ap->in[12] + (size_t)J * 256 * 768; j.gk = ap->in[11] + J * 256; j.scale = 0.10206207261596575f * LOG2E; j.WT = (bf16_t*)(WB + WB_WUQ); j.ldw = 768; j.Ksrc = 256; j.Nsrc = 768; j.ldt = 256; j.cm = 2; return j; }
        j.W = ap->in[14] + (size_t)J * 128 * 1024; j.gk = ap->in[13] + J * 128; j.WT = (bf16_t*)(WB + WB_WUKV); j.ldw = 1024; j.Ksrc = 128; j.Nsrc = 1024; j.ldt = 256; j.cm = 3; return j;
    }
    if (jx == 4) { j.W = ap->in[19] + (size_t)J * 1024 * 2048; j.gk = ap->in[3] + L * 1024; j.WT = (bf16_t*)(WB + WB_WIN); j.ldw = 2048; j.Ksrc = 1024; j.Nsrc = 2048; j.ldt = 1024; return j; }
    if (jx == 5) { j.W = ap->in[29] + (size_t)J * 1024 * 1024; j.WT = (bf16_t*)(WB + WB_WOUT); j.ldw = 1024; j.Ksrc = 1024; j.Nsrc = 1024; j.ldt = 1024; return j; }
    { const int q = jx - 6, which = q >> 2, hh = q & 3;
      j.W = ap->in[22 + which] + ((size_t)J * 4 + hh) * 65536; j.scale = which == 0 ? 0.0625f : 1.f; j.WT = (bf16_t*)(WB + WB_W3) + (size_t)(which * 4 + hh) * 65536; j.ldw = 256; j.Ksrc = 256; j.Nsrc = 256; j.ldt = 256; return j; }
}
template <class ArgsPT>
DEV void prep_layer(const Ctx& c, ArgsPT ap, unsigned char* ws, int L) {
    unsigned char* WB = ws + WS_WB; const bool even = (L & 1) == 0; const int J = L >> 1;
    const int njobs = even ? 8 : 18;
    int total = 0;
    for (int jx = 0; jx < njobs; ++jx) total += pj_items(layer_job(ap, WB, L, even, jx));
    for (int it = c.gw; it < total; it += c.NGW) {
        int r = it, jx = 0;
        PJ j = layer_job(ap, WB, L, even, 0);
        while (r >= pj_items(j)) { r -= pj_items(j); ++jx; j = layer_job(ap, WB, L, even, jx); }
        prep_item(c, j, r);
    }
    if (even) {
        zero_block(c, (bf16_t*)(WB + WB_WIN) + (size_t)432 * 1024, 80, 1024, 1024);
        zero_block(c, (bf16_t*)(WB + WB_WUKV) + 128, 1024, 128, 256);
    } else {
        gatefold_job(c, ap->in[22] + (size_t)J * 4 * 65536, ap->in[23] + (size_t)J * 4 * 65536, ap->in[24] + (size_t)J * 4 * 65536, ap->in[25] + (size_t)J * 3072 * 8, (float*)(ws + WS_G12));
    }
}

namespace pg8 {
constexpr int BM = 256, BK = 64, HALF = 128, HTB = HALF * BK * 2, STAGE_BYTES = 8 * HTB, NXCD = 8, WGM = 8;
__host__ __device__ __forceinline__ int lds_byte(int r, int c) { const int st = (r >> 4) * 2 + (c >> 5), rr = r & 15, cc = c & 31, ob = rr * 64 + cc * 2; return st * 1024 + (ob ^ (((ob >> 9) & 1) << 5)); }
__host__ __device__ __forceinline__ void stage_rc(int b, int& R, int& C) { const int st = b / 1024, sb = b % 1024, swz = sb ^ (((sb >> 9) & 1) << 5); R = (st >> 1) * 16 + swz / 64; C = (st & 1) * 32 + (swz % 64) / 2; }
__host__ __device__ __forceinline__ int perm32(int rho) { const int n = rho >> 4, i = rho & 15; return 8 * (i >> 2) + 4 * n + (i & 3); }
struct Unit { int pm, pn; };
struct StaticOrder {
    int nM, nN, nwg, G, c;
    DEV void init(int nM_, int nN_, int G_, int c_) { nM = nM_; nN = nN_; nwg = nM * nN; G = G_; c = c_; }
    DEV bool next(int i, Unit& u) const {
        const long L = (long)i * G + c; if (L >= nwg) return false;
        int wgid = (int)L; { const int q = nwg / NXCD, r = nwg % NXCD, xcd = wgid % NXCD, off = wgid / NXCD; wgid = (xcd < r ? xcd * (q + 1) : r * (q + 1) + (xcd - r) * q) + off; }
        const int nig = WGM * nN, gid = wgid / nig, fm = gid * WGM, gsz = (nM - fm) < WGM ? (nM - fm) : WGM;
        u.pm = fm + ((wgid % nig) % gsz); u.pn = (wgid % nig) / gsz; return true;
    }
};
template <class Prob>
DEV void gemm_phase(LAS unsigned char* lds, int tid, const StaticOrder& S, const Prob& P) {
    const int wid = __builtin_amdgcn_readfirstlane(tid >> 6), lane = tid & 63, wr = wid >> 2, wc = wid & 3, fr = lane & 15, fq = lane >> 4;
    const int nt = P.nt, lda = P.lda, ldb = P.ldb;
    unsigned voffA[2], voffB[2];
#pragma unroll
    for (int i = 0; i < 2; ++i) { int R, C; stage_rc(tid * 16 + i * 8192, R, C); const int Rb = (R & ~31) + perm32(R & 31);
        voffA[i] = (unsigned)(R * lda + C) * 2u; voffB[i] = (unsigned)(Rb * ldb + C) * 2u; }
    const size_t kstep = (size_t)(BK * 2);
    const size_t hstepA = (size_t)HALF * lda * 2, hstepB = (size_t)HALF * ldb * 2;
    const unsigned ldsw = (unsigned)wid * 1024u;
    const int aoff = lds_byte(wr * 64 + fr, fq * 8), boff = lds_byte(wc * 32 + fr, fq * 8);
#define PG8_SA(b, h) (((b) * 2 + (h)) * HTB)
#define PG8_SB(b, h) ((4 + (b) * 2 + (h)) * HTB)
#define PG8_STAGE(bufoff, gbase, voff) do { _Pragma("unroll") for (int _i = 0; _i < 2; ++_i) \
        __builtin_amdgcn_global_load_lds((const unsigned*)((const char*)(gbase) + (voff)[_i]), (LAS unsigned*)(lds + (bufoff) + ldsw + _i * 8192), 16, 0, 0); } while (0)
#define PG8_LDA(dst, b, h) do { _Pragma("unroll") for (int m = 0; m < 4; ++m) _Pragma("unroll") for (int k = 0; k < 2; ++k) dst[m][k] = *(const LAS bf16x8*)(lds + PG8_SA(b, h) + aoff + m * 2048 + k * 1024); } while (0)
#define PG8_LDB(dst, b, h) do { _Pragma("unroll") for (int n = 0; n < 2; ++n) _Pragma("unroll") for (int k = 0; k < 2; ++k) dst[n][k] = *(const LAS bf16x8*)(lds + PG8_SB(b, h) + boff + n * 2048 + k * 1024); } while (0)
#define PG8_MMA(ai, bj, At, Bt) do { __builtin_amdgcn_s_setprio(1); _Pragma("unroll") for (int m = 0; m < 4; ++m) _Pragma("unroll") for (int n = 0; n < 2; ++n) _Pragma("unroll") for (int k = 0; k < 2; ++k) \
        acc[ai][bj][m][n] = __builtin_amdgcn_mfma_f32_16x16x32_bf16(Bt[n][k], At[m][k], acc[ai][bj][m][n], 0, 0, 0); __builtin_amdgcn_s_setprio(0); } while (0)
#define PG8_WAIT_V(n) asm volatile("s_waitcnt vmcnt(" #n ")" ::: "memory")
#define PG8_WAIT_L(n) asm volatile("s_waitcnt lgkmcnt(" #n ")" ::: "memory")
#define PG8_BAR __builtin_amdgcn_s_barrier()
#define PG8_SCHED __builtin_amdgcn_sched_barrier(0)
    Unit cur, nxt; int ui = 0;
    if (!S.next(0, cur)) return;
    f32x4 acc[2][2][4][2];
#pragma unroll
    for (int a = 0; a < 2; ++a)
#pragma unroll
        for (int b = 0; b < 2; ++b)
#pragma unroll
            for (int m = 0; m < 4; ++m)
#pragma unroll
                for (int n = 0; n < 2; ++n) acc[a][b][m][n] = (f32x4){0.f, 0.f, 0.f, 0.f};
    bf16x8 At[4][2], B0[2][2], B1[2][2];
    const char* cA = P.aptr(cur); const char* cB = P.bptr(cur);
    PG8_STAGE(PG8_SB(0, 0), cB, voffB); PG8_STAGE(PG8_SA(0, 0), cA, voffA); PG8_STAGE(PG8_SB(0, 1), cB + hstepB, voffB); PG8_STAGE(PG8_SA(0, 1), cA + hstepA, voffA);
    if (wr == 1) PG8_BAR;
    PG8_WAIT_V(4); PG8_BAR;
    PG8_STAGE(PG8_SB(1, 0), cB + kstep, voffB); PG8_STAGE(PG8_SA(1, 0), cA + kstep, voffA); PG8_STAGE(PG8_SB(1, 1), cB + hstepB + kstep, voffB);
    PG8_WAIT_V(6); PG8_BAR;
    for (;;) {
        const bool has_next = S.next(ui + 1, nxt);
        const char* nA = has_next ? P.aptr(nxt) : cA; const char* nB = has_next ? P.bptr(nxt) : cB;
        for (int t = 0; t < nt; t += 2) {
            const bool last = (t == nt - 2);
            const char* a1 = cA + (size_t)(t + 1) * kstep;
            const char* a2 = last ? nA : cA + (size_t)(t + 2) * kstep; const char* b2 = last ? nB : cB + (size_t)(t + 2) * kstep;
            const char* a3 = a2 + kstep; const char* b3 = b2 + kstep;
            PG8_LDB(B0, 0, 0); PG8_SCHED; PG8_LDA(At, 0, 0); PG8_STAGE(PG8_SA(1, 1), a1 + hstepA, voffA);
            PG8_WAIT_L(8); PG8_BAR; PG8_WAIT_L(0); PG8_MMA(0, 0, At, B0); PG8_BAR; PG8_SCHED;
            PG8_LDB(B1, 0, 1); PG8_STAGE(PG8_SB(0, 0), b2, voffB);
            PG8_BAR; PG8_WAIT_L(0); PG8_MMA(0, 1, At, B1); PG8_BAR;
            PG8_LDA(At, 0, 1); PG8_STAGE(PG8_SA(0, 0), a2, voffA);
            PG8_BAR; PG8_WAIT_L(0); PG8_MMA(1, 0, At, B0); PG8_BAR; PG8_SCHED;
            PG8_STAGE(PG8_SB(0, 1), b2 + hstepB, voffB);
            PG8_WAIT_V(6); PG8_BAR; PG8_MMA(1, 1, At, B1); PG8_BAR;
            PG8_LDB(B0, 1, 0); PG8_SCHED; PG8_LDA(At, 1, 0); PG8_STAGE(PG8_SA(0, 1), a2 + hstepA, voffA);
            PG8_WAIT_L(8); PG8_BAR; PG8_WAIT_L(0); PG8_MMA(0, 0, At, B0); PG8_BAR; PG8_SCHED;
            PG8_LDB(B1, 1, 1); PG8_STAGE(PG8_SB(1, 0), b3, voffB);
            PG8_BAR; PG8_WAIT_L(0); PG8_MMA(0, 1, At, B1); PG8_BAR;
            PG8_LDA(At, 1, 1); PG8_STAGE(PG8_SA(1, 0), a3, voffA);
            PG8_BAR; PG8_WAIT_L(0); PG8_MMA(1, 0, At, B0); PG8_BAR; PG8_SCHED;
            PG8_STAGE(PG8_SB(1, 1), b3 + hstepB, voffB);
            PG8_WAIT_V(6); PG8_BAR; PG8_MMA(1, 1, At, B1); PG8_BAR;
        }
        P.epi(acc, cur, wr, wc, fr, fq);
        if (!has_next) break;
#pragma unroll
        for (int a = 0; a < 2; ++a)
#pragma unroll
            for (int b = 0; b < 2; ++b)
#pragma unroll
                for (int m = 0; m < 4; ++m)
#pragma unroll
                    for (int n = 0; n < 2; ++n) acc[a][b][m][n] = (f32x4){0.f, 0.f, 0.f, 0.f};
        cur = nxt; cA = nA; cB = nB; ++ui;
    }
    PG8_WAIT_V(0);
    if (wr == 0) PG8_BAR;
    PG8_BAR;
#undef PG8_SA
#undef PG8_SB
#undef PG8_STAGE
#undef PG8_LDA
#undef PG8_LDB
#undef PG8_MMA
#undef PG8_WAIT_V
#undef PG8_WAIT_L
#undef PG8_BAR
#undef PG8_SCHED
}
}
typedef f32x4 Acc[2][2][4][2];

DEV void st8(bf16_t* p, f32x4 a, f32x4 b) { u32x4 o; o.x = pk2(a[0], a[1]); o.y = pk2(a[2], a[3]); o.z = pk2(b[0], b[1]); o.w = pk2(b[2], b[3]); *(u32x4*)p = o; }
DEV float sq4(f32x4 a) { return a[0] * a[0] + a[1] * a[1] + a[2] * a[2] + a[3] * a[3]; }
DEV void rope8(f32x4& a, f32x4& b, const float* cosT, const float* sinT, int row, int fq) {
    const f32x4 c = *(const f32x4*)(cosT + (size_t)row * 16 + 4 * fq), s = *(const f32x4*)(sinT + (size_t)row * 16 + 4 * fq);
    const f32x4 x1 = a, x2 = b;
    a = x1 * c - x2 * s; b = x2 * c + x1 * s;
}

struct ProbPlain {
    const bf16_t* A; const bf16_t* Bt; int lda, ldb, nt;
    bf16_t* out; int ldo; bf16_t* out2; int split;
    const float* rs;
    int act;
    float* ssq; int nslot;
    DEV const char* aptr(const pg8::Unit& u) const { return (const char*)(A + (size_t)u.pm * 256 * lda); }
    DEV const char* bptr(const pg8::Unit& u) const { return (const char*)(Bt + (size_t)u.pn * 256 * ldb); }
    DEV void epi(const Acc& acc, const pg8::Unit& u, int wr, int wc, int fr, int fq) const {
        bf16_t* o = out; int pn = u.pn; if (pn >= split) { o = out2; pn -= split; }
#pragma unroll
        for (int ai = 0; ai < 2; ++ai)
#pragma unroll
            for (int m = 0; m < 4; ++m) {
                const int row = u.pm * 256 + ai * 128 + wr * 64 + m * 16 + fr;
                const float r = rs ? rs[row] : 1.f;
                float ss = 0.f;
#pragma unroll
                for (int bj = 0; bj < 2; ++bj) {
                    f32x4 v0 = acc[ai][bj][m][0] * r, v1 = acc[ai][bj][m][1] * r;
                    if (act == 1) {
#pragma unroll
                        for (int j = 0; j < 4; ++j) { float a = fmaxf(v0[j], 0.f), b = fmaxf(v1[j], 0.f); v0[j] = a * a; v1[j] = b * b; }
                    }
                    ss += sq4(v0) + sq4(v1);
                    st8(o + (size_t)row * ldo + pn * 256 + bj * 128 + wc * 32 + fq * 8, v0, v1);
                }
                if (ssq) { ss += __shfl_xor(ss, 16); ss += __shfl_xor(ss, 32); if (fq == 0) ssq[(size_t)row * nslot + u.pn * 4 + wc] = ss; }
            }
    }
};
struct ProbE1 {
    const bf16_t* A; const bf16_t* Bt; int lda, ldb, nt;
    bf16_t* proj; const float* rs; float* ssqq; float* ssqkv; const float* cosT; const float* sinT;
    DEV const char* aptr(const pg8::Unit& u) const { return (const char*)(A + (size_t)u.pm * 256 * lda); }
    DEV const char* bptr(const pg8::Unit& u) const { return (const char*)(Bt + (size_t)u.pn * 256 * ldb); }
    DEV void epi(const Acc& acc, const pg8::Unit& u, int wr, int wc, int fr, int fq) const {
#pragma unroll
        for (int ai = 0; ai < 2; ++ai)
#pragma unroll
            for (int m = 0; m < 4; ++m) {
                const int row = u.pm * 256 + ai * 128 + wr * 64 + m * 16 + fr;
                const float r = rs[row];
                float ss0 = 0.f, ss1 = 0.f;
#pragma unroll
                for (int bj = 0; bj < 2; ++bj) {
                    f32x4 v0 = acc[ai][bj][m][0] * r, v1 = acc[ai][bj][m][1] * r;
                    if (bj == 0) ss0 = sq4(v0) + sq4(v1); else ss1 = sq4(v0) + sq4(v1);
                    if (u.pn == 1 && bj == 1 && wc == 0) rope8(v0, v1, cosT, sinT, row, fq);
                    st8(proj + (size_t)row * 2048 + u.pn * 256 + bj * 128 + wc * 32 + fq * 8, v0, v1);
                }
                if (u.pn == 0) { float ss = ss0 + ss1; ss += __shfl_xor(ss, 16); ss += __shfl_xor(ss, 32); if (fq == 0) ssqq[(size_t)row * 4 + wc] = ss; }
                if (u.pn == 1) { float ss = ss0; ss += __shfl_xor(ss, 16); ss += __shfl_xor(ss, 32); if (fq == 0) ssqkv[(size_t)row * 4 + wc] = ss; }
            }
    }
};
struct ProbE2 {
    const bf16_t* proj; const bf16_t* Wuq; const bf16_t* Wukv; int lda, ldb, nt;
    bf16_t* Q; bf16_t* KN; bf16_t* V; const float* ssqq; const float* ssqkv; const float* cosT; const float* sinT;
    DEV const char* aptr(const pg8::Unit& u) const { return (const char*)(proj + (size_t)u.pm * 256 * 2048 + (u.pn < 3 ? PJ_CQ : PJ_CKV)); }
    DEV const char* bptr(const pg8::Unit& u) const { return (const char*)(u.pn < 3 ? Wuq + (size_t)u.pn * 256 * 256 : Wukv + (size_t)(u.pn - 3) * 256 * 256); }
    DEV void epi(const Acc& acc, const pg8::Unit& u, int wr, int wc, int fr, int fq) const {
        const bool isq = u.pn < 3; const int t = u.pn - 3;
#pragma unroll
        for (int ai = 0; ai < 2; ++ai)
#pragma unroll
            for (int m = 0; m < 4; ++m) {
                const int row = u.pm * 256 + ai * 128 + wr * 64 + m * 16 + fr;
                const f32x4 p4 = *(const f32x4*)((isq ? ssqq : ssqkv) + (size_t)row * 4);
                const float r = rsqrtf(((p4[0] + p4[1]) + (p4[2] + p4[3])) * (isq ? (1.f / 256.f) : (1.f / 128.f)) + EPS);
#pragma unroll
                for (int bj = 0; bj < 2; ++bj) {
                    f32x4 v0 = acc[ai][bj][m][0] * r, v1 = acc[ai][bj][m][1] * r;
                    if (isq) {
                        const int g32 = u.pn * 8 + bj * 4 + wc;
                        if (g32 % 3 == 2) rope8(v0, v1, cosT, sinT, row, fq);
                        st8(Q + (size_t)row * 768 + u.pn * 256 + bj * 128 + wc * 32 + fq * 8, v0, v1);
                    } else {
                        bf16_t* o = (t < 2) ? KN : V;
                        st8(o + (size_t)row * 512 + (t & 1) * 256 + bj * 128 + wc * 32 + fq * 8, v0, v1);
                    }
                }
            }
    }
};


struct ProbKV {
    const bf16_t* memn; const bf16_t* xkt; int lda, ldb, nt; bf16_t* KX; bf16_t* VX;
    DEV const char* aptr(const pg8::Unit& u) const { return (const char*)(memn + (size_t)(u.pn >> 3) * 256 * 1024); }
    DEV const char* bptr(const pg8::Unit& u) const { return (const char*)(xkt + ((size_t)(u.pn >> 2) * 1024 + (u.pn & 3) * 256) * 1024); }
    DEV void epi(const Acc& acc, const pg8::Unit& u, int wr, int wc, int fr, int fq) const {
        bf16_t* o = (((u.pn >> 2) & 1) ? VX : KX) + (size_t)(u.pn >> 3) * 256 * 1024;
#pragma unroll
        for (int ai = 0; ai < 2; ++ai)
#pragma unroll
            for (int m = 0; m < 4; ++m) {
                const int row = ai * 128 + wr * 64 + m * 16 + fr;
#pragma unroll
                for (int bj = 0; bj < 2; ++bj) st8(o + (size_t)row * 1024 + (u.pn & 3) * 256 + bj * 128 + wc * 32 + fq * 8, acc[ai][bj][m][0], acc[ai][bj][m][1]);
            }
    }
};

DEV bf16x8 tr_frag(const LAS unsigned char* blk_ks_base, int lane) {
    const int hi = lane >> 5;
    const LAS unsigned char* p = blk_ks_base + ((lane >> 4) & 1) * 32 + (lane & 3) * 8 + (4 * hi + ((lane & 15) >> 2)) * 64;
    const s16x4 lo = __builtin_bit_cast(s16x4, __builtin_amdgcn_ds_read_tr16_b64_v4i16((LAS v4i16_t*)p));
    const s16x4 hh = __builtin_bit_cast(s16x4, __builtin_amdgcn_ds_read_tr16_b64_v4i16((LAS v4i16_t*)(p + 512)));
    return (bf16x8){lo[0], lo[1], lo[2], lo[3], hh[0], hh[1], hh[2], hh[3]};
}
DEV bf16x8 pack8(const f32x16& p, int b) {
    u32x4 o; o.x = pk2(p[b], p[b + 1]); o.y = pk2(p[b + 2], p[b + 3]); o.z = pk2(p[b + 4], p[b + 5]); o.w = pk2(p[b + 6], p[b + 7]);
    return __builtin_bit_cast(bf16x8, o);
}
template <int NC1, int NC2, int NVB, int NDVB, bool CAUSAL>
DEV void flash_unit(const Ctx& c, const bf16_t* Qw, int ldq, const bf16_t* K1, int ldk1, const bf16_t* K2, int ldk2, const bf16_t* Vp, int ldv,
                    bf16_t* Ow, int ldo, int NT, int dvb0, int qrel0, int band0) {
    constexpr int NCH = NC1 + NC2, NKD = NCH / 2, KB = NCH * 1024, VB = NVB * 4096, BUF = KB + VB;
    constexpr int NKP = 64 * NCH, KPT = (NKP + 511) / 512, NVP = 256 * NVB, VPT = (NVP + 511) / 512;
    const int tid = c.tid, lane = c.lane, r32 = lane & 31, hi = lane >> 5;
    LAS unsigned char* lds = c.lds;
    bf16x8 qr[NKD];
#pragma unroll
    for (int d0 = 0; d0 < NKD; ++d0) qr[d0] = *(const bf16x8*)(Qw + (size_t)r32 * ldq + d0 * 16 + hi * 8);
    auto g_load = [&](int t, int buf) {
        LAS unsigned char* kb = lds + buf * BUF; LAS unsigned char* vb = kb + KB;
#pragma unroll
        for (int i = 0; i < KPT; ++i) { const int p = tid + 512 * i;
            if (p < NKP) { const int ch = p >> 6, row = t * 64 + (p & 63);
                const bf16_t* src = (ch < NC1) ? K1 + (size_t)row * ldk1 + ch * 8 : K2 + (size_t)row * ldk2 + (ch - NC1) * 8;
                __builtin_amdgcn_global_load_lds((const unsigned*)src, (LAS unsigned*)(kb + (c.wave * 64 + 512 * i) * 16), 16, 0, 0); } }
#pragma unroll
        for (int i = 0; i < VPT; ++i) { const int p = tid + 512 * i;
            if (p < NVP) { const int blk = p >> 8, row = t * 64 + ((p >> 2) & 63), c4 = p & 3;
                __builtin_amdgcn_global_load_lds((const unsigned*)(Vp + (size_t)row * ldv + blk * 32 + c4 * 8), (LAS unsigned*)(vb + (c.wave * 64 + 512 * i) * 16), 16, 0, 0); } }
    };
    float m_run = -INFINITY, l_run = 0.f;
    f32x16 oT[NDVB];
#pragma unroll
    for (int b = 0; b < NDVB; ++b)
#pragma unroll
        for (int r = 0; r < 16; ++r) oT[b][r] = 0.f;
    g_load(0, 0); __syncthreads();
    for (int t = 0; t < NT; ++t) {
        const int buf = t & 1;
        if (t + 1 < NT) g_load(t + 1, buf ^ 1);
        bool active = true;
        if (CAUSAL) { const int jb = t - band0; if (jb >= 0 && 64 * jb > qrel0 + 31) active = false; }
        if (active) {
            const LAS unsigned char* Kb = lds + buf * BUF; const LAS unsigned char* Vb = Kb + KB;
            f32x16 p0, p1;
#pragma unroll
            for (int r = 0; r < 16; ++r) { p0[r] = 0.f; p1[r] = 0.f; }
#pragma unroll
            for (int d0 = 0; d0 < NKD; ++d0) {
                const bf16x8 k0 = *(const LAS bf16x8*)(Kb + (2 * d0 + hi) * 1024 + r32 * 16);
                const bf16x8 k1 = *(const LAS bf16x8*)(Kb + (2 * d0 + hi) * 1024 + r32 * 16 + 512);
                p0 = __builtin_amdgcn_mfma_f32_32x32x16_bf16(k0, qr[d0], p0, 0, 0, 0);
                p1 = __builtin_amdgcn_mfma_f32_32x32x16_bf16(k1, qr[d0], p1, 0, 0, 0);
            }
            if (CAUSAL) { const int jb = t - band0;
                if (jb >= 0) { const int qrel = qrel0 + r32, kb = 64 * jb + 4 * hi;
#pragma unroll
                    for (int r = 0; r < 16; ++r) { const int kv = kb + (r & 3) + 8 * (r >> 2); if (kv > qrel) p0[r] = -INFINITY; if (kv + 32 > qrel) p1[r] = -INFINITY; } } }
            float mx = fmaxf(p0[0], p1[0]);
#pragma unroll
            for (int r = 1; r < 16; ++r) mx = fmaxf(mx, fmaxf(p0[r], p1[r]));
            mx = swap32_max(mx);
            const float mnew = fmaxf(m_run, mx);
            const float alpha = __builtin_amdgcn_exp2f(m_run - mnew);
            float ps = 0.f;
#pragma unroll
            for (int r = 0; r < 16; ++r) { p0[r] = __builtin_amdgcn_exp2f(p0[r] - mnew); p1[r] = __builtin_amdgcn_exp2f(p1[r] - mnew); ps += p0[r] + p1[r]; }
            l_run = l_run * alpha + ps; m_run = mnew;
#pragma unroll
            for (int b = 0; b < NDVB; ++b)
#pragma unroll
                for (int r = 0; r < 16; ++r) oT[b][r] *= alpha;
            bf16x8 pw[4]; pw[0] = pack8(p0, 0); pw[1] = pack8(p0, 8); pw[2] = pack8(p1, 0); pw[3] = pack8(p1, 8);
#pragma unroll
            for (int b = 0; b < NDVB; ++b)
#pragma unroll
                for (int ks = 0; ks < 4; ++ks) {
                    const bf16x8 vf = tr_frag(Vb + (dvb0 + b) * 4096 + ks * 1024, lane);
                    oT[b] = __builtin_amdgcn_mfma_f32_32x32x16_bf16(vf, pw[ks], oT[b], 0, 0, 0);
                }
        }
        __syncthreads();
    }
    const float inv = 1.f / swap32_sum(l_run);
#pragma unroll
    for (int b = 0; b < NDVB; ++b)
#pragma unroll
        for (int g = 0; g < 4; ++g) {
            u32x2 o; o.x = pk2(oT[b][4 * g] * inv, oT[b][4 * g + 1] * inv); o.y = pk2(oT[b][4 * g + 2] * inv, oT[b][4 * g + 3] * inv);
            *(u32x2*)(Ow + (size_t)r32 * ldo + b * 32 + 8 * g + 4 * hi) = o;
        }
}


DEV float gla_cumdecay(const Ctx& c, const bf16_t* PJ, const float* wg, const float* bg, int t0, int head, LAS float* Bm, LAS float* tot, float (&bl)[8]) {
    const int ch = c.lane, w = c.wave;
    float wcol[16];
#pragma unroll
    for (int j = 0; j < 16; ++j) wcol[j] = wg[j * 256 + head * 64 + ch];
    const float bias = bg[head * 64 + ch];
    float run = 0.f;
#pragma unroll
    for (int i = 0; i < 8; ++i) {
        const bf16_t* gl = PJ + (size_t)(t0 + 8 * w + i) * 2048 + PJ_GLR;
        float x = bias;
#pragma unroll
        for (int j = 0; j < 16; ++j) x += bf1(gl[j]) * wcol[j];
        run += logsigmoid_f(x) * (1.f / 16.f);
        bl[i] = run;
    }
    tot[w * 64 + ch] = run;
    __syncthreads();
    float off = 0.f, bend = 0.f;
#pragma unroll
    for (int ww = 0; ww < 8; ++ww) { const float tv = tot[ww * 64 + ch]; if (ww < w) off += tv; bend += tv; }
#pragma unroll
    for (int i = 0; i < 8; ++i) { bl[i] += off; Bm[(8 * w + i) * 64 + ch] = bl[i]; }
    return bend;
}
constexpr int GL_BM = 0, GL_TOT = 16384, GL_QI = 20480, GL_KI = 28672, GL_VI = 36864, GL_RED = 53248;
DEV void gla_load_v(const Ctx& c, const bf16_t* PJ, int t0, int head, LAS unsigned char* VI) {
#pragma unroll
    for (int i = 0; i < 2; ++i) { const int p = c.tid + 512 * i, blk = p >> 8, row = (p >> 2) & 63, c4 = p & 3;
        *(LAS u32x4*)(VI + p * 16) = *(const u32x4*)(PJ + (size_t)(t0 + row) * 2048 + PJ_GV + head * 128 + blk * 32 + c4 * 8); }
}
DEV void gla_a_unit(const Ctx& c, const bf16_t* PJ, const float* wg, const float* bg, int cidx, int head, bf16_t* GST, float* GDEC) {
    LAS unsigned char* lds = c.lds; const int t0 = cidx * 64, ch = c.lane, w = c.wave;
    float bl[8];
    const float bend = gla_cumdecay(c, PJ, wg, bg, t0, head, (LAS float*)(lds + GL_BM), (LAS float*)(lds + GL_TOT), bl);
#pragma unroll
    for (int i = 0; i < 8; ++i) { const int t = 8 * w + i;
        const float kv = bf1(PJ[(size_t)(t0 + t) * 2048 + PJ_GK + head * 64 + ch]) * __expf(bend - bl[i]);
        *(LAS bf16_t*)(lds + GL_KI + (ch >> 5) * 4096 + t * 64 + (ch & 31) * 2) = f2bf(kv); }
    gla_load_v(c, PJ, t0, head, lds + GL_VI);
    if (w == 0) GDEC[(cidx * 4 + head) * 64 + ch] = __expf(bend);
    __syncthreads();
    const int dvb = w >> 1, dkb = w & 1, r32 = c.lane & 31, hi = c.lane >> 5;
    f32x16 acc;
#pragma unroll
    for (int r = 0; r < 16; ++r) acc[r] = 0.f;
#pragma unroll
    for (int ks = 0; ks < 4; ++ks) {
        const bf16x8 a = tr_frag(lds + GL_VI + dvb * 4096 + ks * 1024, c.lane), b = tr_frag(lds + GL_KI + dkb * 4096 + ks * 1024, c.lane);
        acc = __builtin_amdgcn_mfma_f32_32x32x16_bf16(a, b, acc, 0, 0, 0);
    }
    bf16_t* o = GST + ((size_t)(cidx * 4 + head) * 128 + dvb * 32) * 64 + dkb * 32 + r32;
#pragma unroll
    for (int r = 0; r < 16; ++r) o[(size_t)crow(r, hi) * 64] = f2bf(acc[r]);
    __syncthreads();
}
DEV void gla_scan(const Ctx& c, bf16_t* GST, const float* GDEC) {
    const int e = c.vcu * NTHREADS + c.tid;
    if (e >= 4 * 128 * 64) return;
    const int hh = e >> 13, dk = e & 63, rem = e & 8191;
    float st = 0.f;
    for (int cb = 0; cb < 256; cb += 8) {
        float u[8], a[8];
#pragma unroll
        for (int i = 0; i < 8; ++i) { u[i] = bf1(GST[(size_t)((cb + i) * 4 + hh) * 8192 + rem]); a[i] = GDEC[((cb + i) * 4 + hh) * 64 + dk]; }
#pragma unroll
        for (int i = 0; i < 8; ++i) { GST[(size_t)((cb + i) * 4 + hh) * 8192 + rem] = f2bf(st); st = a[i] * st + u[i]; }
    }
}
DEV void gla_c_unit(const Ctx& c, const bf16_t* PJ, const float* wg, const float* bg, const float* gnorm, int cidx, int head, const bf16_t* GST, bf16_t* CAT) {
    LAS unsigned char* lds = c.lds; const int t0 = cidx * 64, ch = c.lane, w = c.wave;
    float bl[8];
    (void)gla_cumdecay(c, PJ, wg, bg, t0, head, (LAS float*)(lds + GL_BM), (LAS float*)(lds + GL_TOT), bl);
#pragma unroll
    for (int i = 0; i < 8; ++i) { const int t = 8 * w + i;
        const float qv = bf1(PJ[(size_t)(t0 + t) * 2048 + PJ_GQ + head * 64 + ch]) * __expf(bl[i]) * 0.125f;
        const float kv = bf1(PJ[(size_t)(t0 + t) * 2048 + PJ_GK + head * 64 + ch]) * __expf(fminf(-bl[i], 60.f));
        *(LAS bf16_t*)(lds + GL_QI + (ch >> 3) * 1024 + t * 16 + (ch & 7) * 2) = f2bf(qv);
        *(LAS bf16_t*)(lds + GL_KI + (ch >> 3) * 1024 + t * 16 + (ch & 7) * 2) = f2bf(kv); }
    gla_load_v(c, PJ, t0, head, lds + GL_VI);
    __syncthreads();
    const int dvb = w >> 1, tb = w & 1, r32 = c.lane & 31, hi = c.lane >> 5;
    bf16x8 qf[4];
#pragma unroll
    for (int d0 = 0; d0 < 4; ++d0) qf[d0] = *(const LAS bf16x8*)(lds + GL_QI + (2 * d0 + hi) * 1024 + (tb * 32 + r32) * 16);
    bf16x8 pw[4];
#pragma unroll
    for (int sb = 0; sb < 2; ++sb) {
        f32x16 aT;
#pragma unroll
        for (int r = 0; r < 16; ++r) aT[r] = 0.f;
        if (sb <= tb) {
#pragma unroll
            for (int d0 = 0; d0 < 4; ++d0) {
                const bf16x8 kf = *(const LAS bf16x8*)(lds + GL_KI + (2 * d0 + hi) * 1024 + (sb * 32 + r32) * 16);
                aT = __builtin_amdgcn_mfma_f32_32x32x16_bf16(kf, qf[d0], aT, 0, 0, 0);
            }
            if (sb == tb) {
#pragma unroll
                for (int r = 0; r < 16; ++r) if (crow(r, hi) > r32) aT[r] = 0.f;
            }
        }
        pw[2 * sb] = pack8(aT, 0); pw[2 * sb + 1] = pack8(aT, 8);
    }
    f32x16 oT;
#pragma unroll
    for (int r = 0; r < 16; ++r) oT[r] = 0.f;
#pragma unroll
    for (int ks = 0; ks < 4; ++ks) {
        if (ks < 2 * (tb + 1)) { const bf16x8 vf = tr_frag(lds + GL_VI + dvb * 4096 + ks * 1024, c.lane); oT = __builtin_amdgcn_mfma_f32_32x32x16_bf16(vf, pw[ks], oT, 0, 0, 0); }
    }
    const bf16_t* stp = GST + ((size_t)(cidx * 4 + head) * 128 + dvb * 32 + r32) * 64 + hi * 8;
#pragma unroll
    for (int d0 = 0; d0 < 4; ++d0) { const bf16x8 sf = *(const bf16x8*)(stp + d0 * 16); oT = __builtin_amdgcn_mfma_f32_32x32x16_bf16(sf, qf[d0], oT, 0, 0, 0); }
    float my = 0.f;
#pragma unroll
    for (int r = 0; r < 16; ++r) my += oT[r] * oT[r];
    my = swap32_sum(my);
    LAS float* red = (LAS float*)(lds + GL_RED);
    if (hi == 0) red[dvb * 64 + tb * 32 + r32] = my;
    __syncthreads();
    const int t = tb * 32 + r32;
    const float rs = rsqrtf((red[t] + red[64 + t] + red[128 + t] + red[192 + t]) * (1.f / 128.f) + EPS);
#pragma unroll
    for (int g = 0; g < 4; ++g) {
        const int dv = dvb * 32 + 8 * g + 4 * hi;
        const u32x2 rr = *(const u32x2*)(PJ + (size_t)(t0 + t) * 2048 + PJ_R + head * 128 + dv);
        const f32x4 gn = *(const f32x4*)(gnorm + dv);
        const float v0 = oT[4 * g] * rs * gn[0] * silu_f(bflo(rr.x)), v1 = oT[4 * g + 1] * rs * gn[1] * silu_f(bfhi(rr.x));
        const float v2 = oT[4 * g + 2] * rs * gn[2] * silu_f(bflo(rr.y)), v3 = oT[4 * g + 3] * rs * gn[3] * silu_f(bfhi(rr.y));
        u32x2 o; o.x = pk2(v0, v1); o.y = pk2(v2, v3);
        *(u32x2*)(CAT + (size_t)(t0 + t) * 1024 + 512 + head * 128 + dv) = o;
    }
    __syncthreads();
}


DEV void conv_phase(const Ctx& c, const bf16_t* XM, const float* convw, const float* convb, const float* G12  , const float* bgates,
                    bf16_t* XC, float* gates) {
    LAS float* gl = (LAS float*)c.lds;
    for (int i = c.tid; i < 16 * 1024 / 4; i += NTHREADS) *(LAS f32x4*)(gl + 4 * i) = *(const f32x4*)(G12 + 4 * i);
    __syncthreads();
    for (int blk = c.gw; blk < S / 8; blk += c.NGW) {
        const int t0 = blk * 8;
        float ga[8][8];
#pragma unroll
        for (int rr = 0; rr < 8; ++rr)
#pragma unroll
            for (int g = 0; g < 8; ++g) ga[rr][g] = 0.f;
#pragma unroll 1
        for (int j = 0; j < 4; ++j) {
            const int ch = 4 * c.lane + 256 * j;
            const f32x4 cb = *(const f32x4*)(convb + ch);
            f32x4 cw[4];
#pragma unroll
            for (int i = 0; i < 4; ++i) cw[i] = *(const f32x4*)(convw + i * 1024 + ch);
            f32x4 w1[8], w2[8];
#pragma unroll
            for (int g = 0; g < 8; ++g) { w1[g] = *(const LAS f32x4*)(gl + g * 1024 + ch); w2[g] = *(const LAS f32x4*)(gl + (8 + g) * 1024 + ch); }
            f32x4 win[4];
#pragma unroll
            for (int i = 0; i < 3; ++i) {
                const int t = t0 - 3 + i;
                if (t >= 0) { const u32x2 mm = *(const u32x2*)(XM + (size_t)t * 1024 + ch); win[i] = (f32x4){bflo(mm.x), bfhi(mm.x), bflo(mm.y), bfhi(mm.y)}; }
                else win[i] = (f32x4){0.f, 0.f, 0.f, 0.f};
            }
#pragma unroll
            for (int rr = 0; rr < 8; ++rr) {
                const int t = t0 + rr;
                const u32x2 mm = *(const u32x2*)(XM + (size_t)t * 1024 + ch);
                win[3] = (f32x4){bflo(mm.x), bfhi(mm.x), bflo(mm.y), bfhi(mm.y)};
                const f32x4 y = cb + cw[0] * win[0] + cw[1] * win[1] + cw[2] * win[2] + cw[3] * win[3];
                f32x4 xc;
#pragma unroll
                for (int e = 0; e < 4; ++e) xc[e] = y[e] / (1.f + __expf(-y[e]));
                u32x2 o; o.x = pk2(xc[0], xc[1]); o.y = pk2(xc[2], xc[3]);
                *(u32x2*)(XC + (size_t)t * 1024 + ch) = o;
#pragma unroll
                for (int g = 0; g < 8; ++g)
                    ga[rr][g] += xc[0] * w1[g][0] + xc[1] * w1[g][1] + xc[2] * w1[g][2] + xc[3] * w1[g][3] + win[3][0] * w2[g][0] + win[3][1] * w2[g][1] + win[3][2] * w2[g][2] + win[3][3] * w2[g][3];
                win[0] = win[1]; win[1] = win[2]; win[2] = win[3];
            }
        }
#pragma unroll
        for (int rr = 0; rr < 8; ++rr) {
            float v = 0.f;
#pragma unroll
            for (int g = 0; g < 8; ++g) { const float sg = wave_sum(ga[rr][g]); if (c.lane == g) v = sg; }
            if (c.lane < 8) gates[(size_t)(t0 + rr) * 8 + c.lane] = v + bgates[c.lane];
        }
    }
    __syncthreads();
}
struct ProbO3 {
    const bf16_t* XC; const bf16_t* XM; const bf16_t* W3; int lda, ldb, nt; bf16_t* MQ; bf16_t* MK; bf16_t* MV;
    DEV const char* aptr(const pg8::Unit& u) const { return (const char*)(((u.pn >> 2) == 2 ? XM : XC) + (size_t)u.pm * 256 * 1024 + (u.pn & 3) * 256); }
    DEV const char* bptr(const pg8::Unit& u) const { return (const char*)(W3 + (size_t)u.pn * 65536); }
    DEV void epi(const Acc& acc, const pg8::Unit& u, int wr, int wc, int fr, int fq) const {
        const int which = u.pn >> 2; bf16_t* o = MQ + (size_t)which * (16u << 20) + (u.pn & 3) * 256;
#pragma unroll
        for (int ai = 0; ai < 2; ++ai)
#pragma unroll
            for (int m = 0; m < 4; ++m) {
                const int row = u.pm * 256 + ai * 128 + wr * 64 + m * 16 + fr;
#pragma unroll
                for (int bj = 0; bj < 2; ++bj) st8(o + (size_t)row * 1024 + bj * 128 + wc * 32 + fq * 8, acc[ai][bj][m][0], acc[ai][bj][m][1]);
            }
    }
};


constexpr int ML_ARR = 131072, ML_BT = ML_ARR, ML_GT = ML_ARR + 1024, ML_CM = ML_ARR + 2048, ML_WT = ML_ARR + 3072, ML_SCR = ML_ARR + 4096, ML_LN = ML_ARR + 4352;
constexpr size_t ML_MSTAT_G = 0, ML_MSTAT_M = 4096, ML_NLOC = 8192;
DEV void mlstm_tokens(const Ctx& c, const float* gates, int t0, int head, float m_in, float& bend, float& gmax) {
    LAS float* Bt = (LAS float*)(c.lds + ML_BT); LAS float* Gt = (LAS float*)(c.lds + ML_GT); LAS float* CMt = (LAS float*)(c.lds + ML_CM); LAS float* scr = (LAS float*)(c.lds + ML_SCR);
    const int tid = c.tid, lane = c.lane, w = c.wave; const bool act = tid < 256;
    float v = act ? logsigmoid_f(gates[(size_t)(t0 + tid) * 8 + 4 + head]) : 0.f;
    const float ii = act ? gates[(size_t)(t0 + tid) * 8 + head] : 0.f;
#pragma unroll
    for (int o = 1; o < 64; o <<= 1) { const float t = __shfl_up(v, o); if (lane >= o) v += t; }
    if (lane == 63 && w < 4) scr[w] = v;
    __syncthreads();
    float off = 0.f;
#pragma unroll
    for (int ww = 0; ww < 4; ++ww) if (ww < w) off += scr[ww];
    const float b = v + off, g = ii - b;
    float mx = g;
#pragma unroll
    for (int o = 1; o < 64; o <<= 1) { const float t = __shfl_up(mx, o); if (lane >= o) mx = fmaxf(mx, t); }
    if (lane == 63 && w < 4) scr[8 + w] = mx;
    __syncthreads();
    float pm = m_in;
#pragma unroll
    for (int ww = 0; ww < 4; ++ww) if (ww < w) pm = fmaxf(pm, scr[8 + ww]);
    if (act) { Bt[tid] = b; Gt[tid] = g; CMt[tid] = fmaxf(mx, pm); }
    bend = (scr[0] + scr[1]) + (scr[2] + scr[3]); gmax = fmaxf(fmaxf(scr[8], scr[9]), fmaxf(scr[10], scr[11]));
    __syncthreads();
}
DEV void mlstm_a_unit(const Ctx& c, const float* gates, const bf16_t* MK, const bf16_t* MV, int cidx, int head, bf16_t* CST, float* MST) {
    LAS unsigned char* lds = c.lds; const int t0 = cidx * 256, tid = c.tid, lane = c.lane, w = c.wave, r32 = lane & 31, hi = lane >> 5;
    float bend, G;
    mlstm_tokens(c, gates, t0, head, -INFINITY, bend, G);
    LAS float* Gt = (LAS float*)(lds + ML_GT); LAS float* Wt = (LAS float*)(lds + ML_WT);
    if (tid < 256) Wt[tid] = __expf(Gt[tid] - G);
    if (tid == 0) { MST[ML_MSTAT_G + (cidx * 4 + head) * 2] = G; MST[ML_MSTAT_G + (cidx * 4 + head) * 2 + 1] = bend; }
    const int dvb0 = (w >> 1) * 2, dkb0 = (w & 1) * 4;
    f32x16 acc[2][4];
#pragma unroll
    for (int i = 0; i < 2; ++i)
#pragma unroll
        for (int jj = 0; jj < 4; ++jj)
#pragma unroll
            for (int r = 0; r < 16; ++r) acc[i][jj][r] = 0.f;
    float nl = 0.f;
    for (int kt = 0; kt < 4; ++kt) {
        __syncthreads();
#pragma unroll 1
        for (int i = 0; i < 4; ++i) {
            const int p = tid + 512 * i, blk = p >> 8, row = (p >> 2) & 63, c4 = p & 3;
            const size_t go = (size_t)(t0 + 64 * kt + row) * 1024 + head * 256 + blk * 32 + c4 * 8;
            __builtin_amdgcn_global_load_lds((const unsigned*)(MV + go), (LAS unsigned*)(lds + (w * 64 + 512 * i) * 16), 16, 0, 0);
            const u32x4 kk = *(const u32x4*)(MK + go);
            const float ws = Wt[64 * kt + row];
            u32x4 o; o.x = pk2(bflo(kk.x) * ws, bfhi(kk.x) * ws); o.y = pk2(bflo(kk.y) * ws, bfhi(kk.y) * ws); o.z = pk2(bflo(kk.z) * ws, bfhi(kk.z) * ws); o.w = pk2(bflo(kk.w) * ws, bfhi(kk.w) * ws);
            *(LAS u32x4*)(lds + 32768 + p * 16) = o;
        }
        __syncthreads();
#pragma unroll
        for (int ks = 0; ks < 4; ++ks) {
            bf16x8 a[2], b[4];
#pragma unroll
            for (int i = 0; i < 2; ++i) a[i] = tr_frag(lds + (dvb0 + i) * 4096 + ks * 1024, lane);
#pragma unroll
            for (int jj = 0; jj < 4; ++jj) b[jj] = tr_frag(lds + 32768 + (dkb0 + jj) * 4096 + ks * 1024, lane);
#pragma unroll
            for (int i = 0; i < 2; ++i)
#pragma unroll
                for (int jj = 0; jj < 4; ++jj) acc[i][jj] = __builtin_amdgcn_mfma_f32_32x32x16_bf16(a[i], b[jj], acc[i][jj], 0, 0, 0);
        }
        if (tid < 256) { const LAS bf16_t* kc = (const LAS bf16_t*)(lds + 32768 + (tid >> 5) * 4096 + (tid & 31) * 2);
            for (int row = 0; row < 64; ++row) nl += bf1(kc[row * 32]); }
    }
    bf16_t* o = CST + (size_t)(cidx * 4 + head) * 65536;
#pragma unroll
    for (int i = 0; i < 2; ++i)
#pragma unroll
        for (int jj = 0; jj < 4; ++jj)
#pragma unroll
            for (int r = 0; r < 16; ++r) o[(size_t)((dvb0 + i) * 32 + crow(r, hi)) * 256 + (dkb0 + jj) * 32 + r32] = f2bf(acc[i][jj][r]);
    if (tid < 256) MST[ML_NLOC + (size_t)(cidx * 4 + head) * 256 + tid] = nl;
    __syncthreads();
}
DEV void mlstm_scan(const Ctx& c, bf16_t* CST, float* MST) {
    const int gidx = c.vcu * NTHREADS + c.tid;
#pragma unroll 1
    for (int rep = 0; rep < 3; ++rep) {
        const int e = rep < 2 ? gidx + rep * 131072 : gidx;
        if (rep == 2 && gidx >= 1024) break;
        if (rep < 2 && e >= 262144) continue;
        const int hh = rep < 2 ? (e >> 16) : (e >> 8); const int el = rep < 2 ? (e & 65535) : (e & 255);
        float m = 0.f, st = 0.f;
        for (int cb = 0; cb < 63; cb += 7) {
            float u[7], G[7], be[7];
#pragma unroll
            for (int i = 0; i < 7; ++i) { const int ci = (cb + i) * 4 + hh;
                u[i] = rep < 2 ? bf1(CST[(size_t)ci * 65536 + el]) : MST[ML_NLOC + (size_t)ci * 256 + el];
                G[i] = MST[ML_MSTAT_G + ci * 2]; be[i] = MST[ML_MSTAT_G + ci * 2 + 1]; }
#pragma unroll
            for (int i = 0; i < 7; ++i) { const int ci = (cb + i) * 4 + hh;
                const float M = fmaxf(m, G[i]);
                st = __expf(m - M) * st + __expf(G[i] - M) * u[i];
                m = be[i] + M;
                if (rep < 2) CST[(size_t)ci * 65536 + el] = f2bf(st); else MST[ML_NLOC + (size_t)ci * 256 + el] = st;
                if (rep == 2 && el == 0) MST[ML_MSTAT_M + ci] = m; }
        }
    }
}
DEV void mlstm_c_unit(const Ctx& c, const float* gates, const bf16_t* MQ, const bf16_t* MK, const bf16_t* MV, const bf16_t* CST, const float* MST,
                      const bf16_t* XC, const bf16_t* Z, const float* ghn, const float* skip, bf16_t* OUTM, int cidx, int head, int rhf) {
    constexpr int KB = 32768, BUF = 65536;
    LAS unsigned char* lds = c.lds; const int t0 = cidx * 256, tid = c.tid, lane = c.lane, w = c.wave, r32 = lane & 31, hi = lane >> 5;
    const int rg = w >> 1, dvh = w & 1;
    const float m_in = cidx > 0 ? MST[ML_MSTAT_M + (cidx - 1) * 4 + head] : 0.f;
    float bend, gmx;
    mlstm_tokens(c, gates, t0, head, m_in, bend, gmx);
    LAS float* Bt = (LAS float*)(lds + ML_BT); LAS float* Gt = (LAS float*)(lds + ML_GT); LAS float* CMt = (LAS float*)(lds + ML_CM); LAS float* Nt = (LAS float*)(lds + ML_WT);
    if (tid < 256) Nt[tid] = cidx > 0 ? MST[ML_NLOC + (size_t)((cidx - 1) * 4 + head) * 256 + tid] : 0.f;
    auto g_load = [&](int kt, int buf) {
        LAS unsigned char* kb = lds + buf * BUF; LAS unsigned char* vb = kb + KB;
#pragma unroll
        for (int i = 0; i < 4; ++i) { const int p = tid + 512 * i;
            { const int ch = p >> 6, row = t0 + kt * 64 + (p & 63);
              __builtin_amdgcn_global_load_lds((const unsigned*)(MK + (size_t)row * 1024 + head * 256 + ch * 8), (LAS unsigned*)(kb + (w * 64 + 512 * i) * 16), 16, 0, 0); }
            { const int blk = p >> 8, row = t0 + kt * 64 + ((p >> 2) & 63), c4 = p & 3;
              __builtin_amdgcn_global_load_lds((const unsigned*)(MV + (size_t)row * 1024 + head * 256 + blk * 32 + c4 * 8), (LAS unsigned*)(vb + (w * 64 + 512 * i) * 16), 16, 0, 0); } }
    };
    const int NT = 2 * rhf + 2;
    g_load(0, 0);
    const int tl = 128 * rhf + 32 * rg + r32;
    bf16x8 qr[16];
    { const bf16_t* qp = MQ + (size_t)(t0 + tl) * 1024 + head * 256 + hi * 8;
#pragma unroll
      for (int d0 = 0; d0 < 16; ++d0) qr[d0] = *(const bf16x8*)(qp + d0 * 16); }
    __syncthreads();
    const float Mt = CMt[tl], bt = Bt[tl];
    f32x16 oT[4];
#pragma unroll
    for (int b = 0; b < 4; ++b)
#pragma unroll
        for (int r = 0; r < 16; ++r) oT[b][r] = 0.f;
    float den_inter = 0.f;
    if (cidx > 0) {
        const float winter = __expf(m_in - Mt);
        const bf16_t* cp = CST + (size_t)((cidx - 1) * 4 + head) * 65536 + (size_t)(dvh * 128 + r32) * 256 + hi * 8;
#pragma unroll
        for (int b = 0; b < 4; ++b)
#pragma unroll
            for (int d0 = 0; d0 < 16; ++d0) { const bf16x8 cf = *(const bf16x8*)(cp + (size_t)b * 32 * 256 + d0 * 16); oT[b] = __builtin_amdgcn_mfma_f32_32x32x16_bf16(cf, qr[d0], oT[b], 0, 0, 0); }
#pragma unroll
        for (int b = 0; b < 4; ++b)
#pragma unroll
            for (int r = 0; r < 16; ++r) oT[b][r] *= winter;
        float qn = 0.f;
#pragma unroll
        for (int d0 = 0; d0 < 16; ++d0) { const u32x4 qq = __builtin_bit_cast(u32x4, qr[d0]); const LAS float* np = Nt + d0 * 16 + hi * 8;
            qn += bflo(qq.x) * np[0] + bfhi(qq.x) * np[1] + bflo(qq.y) * np[2] + bfhi(qq.y) * np[3] + bflo(qq.z) * np[4] + bfhi(qq.z) * np[5] + bflo(qq.w) * np[6] + bfhi(qq.w) * np[7]; }
        den_inter = winter * swap32_sum(qn);
    }
    float dsum = 0.f;
    for (int kt = 0; kt < NT; ++kt) {
        const int buf = kt & 1;
        if (kt + 1 < NT) g_load(kt + 1, buf ^ 1);
        if (64 * kt <= 128 * rhf + 32 * rg + 31) {
            const LAS unsigned char* Kb = lds + buf * BUF; const LAS unsigned char* Vb = Kb + KB;
            f32x16 p0, p1;
#pragma unroll
            for (int r = 0; r < 16; ++r) { p0[r] = 0.f; p1[r] = 0.f; }
#pragma unroll
            for (int d0 = 0; d0 < 16; ++d0) {
                const bf16x8 k0 = *(const LAS bf16x8*)(Kb + (2 * d0 + hi) * 1024 + r32 * 16);
                const bf16x8 k1 = *(const LAS bf16x8*)(Kb + (2 * d0 + hi) * 1024 + r32 * 16 + 512);
                p0 = __builtin_amdgcn_mfma_f32_32x32x16_bf16(k0, qr[d0], p0, 0, 0, 0);
                p1 = __builtin_amdgcn_mfma_f32_32x32x16_bf16(k1, qr[d0], p1, 0, 0, 0);
            }
#pragma unroll
            for (int q4 = 0; q4 < 4; ++q4) {
                const int s0 = 64 * kt + 8 * q4 + 4 * hi;
                const f32x4 g0 = *(const LAS f32x4*)(Gt + s0), g1 = *(const LAS f32x4*)(Gt + s0 + 32);
#pragma unroll
                for (int e = 0; e < 4; ++e) {
                    const float w0 = (s0 + e <= tl) ? __expf(g0[e] - Mt) : 0.f, w1 = (s0 + 32 + e <= tl) ? __expf(g1[e] - Mt) : 0.f;
                    p0[4 * q4 + e] *= w0; p1[4 * q4 + e] *= w1; dsum += p0[4 * q4 + e] + p1[4 * q4 + e];
                }
            }
            bf16x8 pw[4]; pw[0] = pack8(p0, 0); pw[1] = pack8(p0, 8); pw[2] = pack8(p1, 0); pw[3] = pack8(p1, 8);
#pragma unroll
            for (int b = 0; b < 4; ++b)
#pragma unroll
                for (int ks = 0; ks < 4; ++ks) { const bf16x8 vf = tr_frag(Vb + (dvh * 4 + b) * 4096 + ks * 1024, lane); oT[b] = __builtin_amdgcn_mfma_f32_32x32x16_bf16(vf, pw[ks], oT[b], 0, 0, 0); }
        }
        __syncthreads();
    }
    const float den = swap32_sum(dsum) + den_inter;
    const float inv = 1.f / fmaxf(fabsf(den), __expf(-(bt + Mt)));
    float s1 = 0.f, s2 = 0.f;
#pragma unroll
    for (int b = 0; b < 4; ++b)
#pragma unroll
        for (int r = 0; r < 16; ++r) { oT[b][r] *= inv; s1 += oT[b][r]; s2 += oT[b][r] * oT[b][r]; }
    s1 = swap32_sum(s1); s2 = swap32_sum(s2);
    LAS float* LN = (LAS float*)(lds + ML_LN);
    if (hi == 0) { LN[(dvh * 128 + rg * 32 + r32) * 2] = s1; LN[(dvh * 128 + rg * 32 + r32) * 2 + 1] = s2; }
    __syncthreads();
    { const int ot = ((dvh ^ 1) * 128 + rg * 32 + r32) * 2; s1 += LN[ot]; s2 += LN[ot + 1]; }
    const float mu = s1 * (1.f / 256.f), rstd = rsqrtf(fmaxf(s2 * (1.f / 256.f) - mu * mu, 0.f) + EPS);
    const size_t grow = (size_t)(t0 + tl) * 1024 + head * 256;
#pragma unroll
    for (int b = 0; b < 4; ++b)
#pragma unroll
        for (int g = 0; g < 4; ++g) {
            const int dv = dvh * 128 + b * 32 + 8 * g + 4 * hi;
            const f32x4 gh = *(const f32x4*)(ghn + head * 256 + dv), sk = *(const f32x4*)(skip + head * 256 + dv);
            const u32x2 xx = *(const u32x2*)(XC + grow + dv), zz = *(const u32x2*)(Z + grow + dv);
            const float x0 = bflo(xx.x), x1 = bfhi(xx.x), x2 = bflo(xx.y), x3 = bfhi(xx.y);
            const float v0 = ((oT[b][4 * g] - mu) * rstd * gh[0] + sk[0] * x0) * silu_f(bflo(zz.x));
            const float v1 = ((oT[b][4 * g + 1] - mu) * rstd * gh[1] + sk[1] * x1) * silu_f(bfhi(zz.x));
            const float v2 = ((oT[b][4 * g + 2] - mu) * rstd * gh[2] + sk[2] * x2) * silu_f(bflo(zz.y));
            const float v3 = ((oT[b][4 * g + 3] - mu) * rstd * gh[3] + sk[3] * x3) * silu_f(bfhi(zz.y));
            u32x2 o; o.x = pk2(v0, v1); o.y = pk2(v2, v3);
            *(u32x2*)(OUTM + grow + dv) = o;
        }
    __syncthreads();
}

DEV void norm_phase(const Ctx& c, const bf16_t* mix, const float* ssq16, const float* gpost, float* hout  , bf16_t* hb, float* rsx) {
    f32x4 g[4];
#pragma unroll
    for (int j = 0; j < 4; ++j) g[j] = *(const f32x4*)(gpost + 4 * c.lane + 256 * j);
    for (int row = c.gw; row < S; row += c.NGW) {
        const float* sp = ssq16 + (size_t)row * 16;
        float ssq = 0.f;
#pragma unroll
        for (int i = 0; i < 16; ++i) ssq += sp[i];
        const float rp = rsqrtf(ssq * (1.f / 1024.f) + EPS);
        const bf16_t* mr = mix + (size_t)row * D; bf16_t* br = hb + (size_t)row * D;
        f32x4 v[4]; float s2 = 0.f;
#pragma unroll
        for (int j = 0; j < 4; ++j) {
            const u32x2 mm = *(const u32x2*)(mr + 4 * c.lane + 256 * j);
            const u32x2 hh = *(const u32x2*)(br + 4 * c.lane + 256 * j);
            const f32x4 hv = {bflo(hh.x), bfhi(hh.x), bflo(hh.y), bfhi(hh.y)};
            f32x4 mv = {bflo(mm.x), bfhi(mm.x), bflo(mm.y), bfhi(mm.y)};
            v[j] = hv + mv * g[j] * rp;
            s2 += sq4(v[j]);
        }
        s2 = wave_sum(s2);
#pragma unroll
        for (int j = 0; j < 4; ++j) {
            if (hout) *(f32x4*)(hout + (size_t)row * D + 4 * c.lane + 256 * j) = v[j];
            u32x2 o; o.x = pk2(v[j][0], v[j][1]); o.y = pk2(v[j][2], v[j][3]);
            *(u32x2*)(br + 4 * c.lane + 256 * j) = o;
        }
        if (c.lane == 0) rsx[row] = rsqrtf(s2 * (1.f / 1024.f) + EPS);
    }
}


#define PROBE 0
#define MULTI_LAUNCH 0
#ifndef REP_K
#define REP_K -1
#endif
#ifndef REP_N
#define REP_N 1
#endif
#define REPS(k) (((k) == REP_K) ? REP_N : 1)
#if PROBE
DEV void probe_err(unsigned* ctl, float err) { if (!(err == err)) err = 1e30f; atomicMax(ctl + 512, __float_as_uint(fabsf(err))); }
DEV void probe_rms(unsigned* ctl, float got, float ref) { float d = got - ref; if (!(d == d)) d = 1e15f; atomicAdd((float*)ctl + 513, d * d); atomicAdd((float*)ctl + 514, ref * ref); }
__global__ void probe_report(const unsigned* ctl, const float* x, float* out) {
    float e = __uint_as_float(ctl[512]);
    int k = e < 0.02f ? 0 : e < 0.05f ? 1 : e < 0.1f ? 2 : e < 0.3f ? 3 : e < 1.f ? 4 : e < 1e29f ? 5 : 6;
    const float den = ((const float*)ctl)[514];
    if (den > 0.f) { e = sqrtf(((const float*)ctl)[513] / den); k = e < 0.003f ? 0 : e < 0.01f ? 1 : e < 0.03f ? 2 : e < 0.1f ? 3 : e < 0.3f ? 4 : e < 1e6f ? 5 : 6; }
    const float f = 1.f + (float)k;
    for (size_t i = blockIdx.x * (size_t)blockDim.x + threadIdx.x; i < (size_t)S * D; i += (size_t)gridDim.x * blockDim.x) out[i] = x[i] * f;
}
__global__ void probe_e1(Args a, int layer) {
    __shared__ float hn[1024]; __shared__ float red[8]; __shared__ float ref[1968];
    const int row = (blockIdx.x * 131 + 7) % S, tid = threadIdx.x, j = layer >> 1;
    const float* x = a.in[0] + (size_t)row * D; const float* g = a.in[3] + layer * 1024; const float* W = a.in[10] + (size_t)j * 1024 * 1968;
    float s2 = 0.f; for (int k = tid; k < 1024; k += 512) s2 += x[k] * x[k];
    s2 = wave_sum(s2); if ((tid & 63) == 0) red[tid >> 6] = s2; __syncthreads();
    float tot = 0.f; for (int i = 0; i < 8; ++i) tot += red[i];
    const float rs = rsqrtf(tot / 1024.f + EPS);
    for (int k = tid; k < 1024; k += 512) hn[k] = x[k] * rs * g[k];
    __syncthreads();
    for (int n = tid; n < 1968; n += 512) { float acc = 0.f; for (int k = 0; k < 1024; ++k) acc += hn[k] * W[(size_t)k * 1968 + n]; ref[n] = acc; }
    __syncthreads();
    const int pos = ((const int*)a.in[2])[row];
    if (tid < 16) { const float inv = powf(10000.f, -(float)tid / 16.f); const float ang = (float)pos * inv; const float c = cosf(ang), sn = sinf(ang);
        const float x1 = ref[384 + tid], x2 = ref[384 + 16 + tid]; ref[384 + tid] = x1 * c - x2 * sn; ref[384 + 16 + tid] = x2 * c + x1 * sn; }
    __syncthreads();
    const bf16_t* proj = (const bf16_t*)(a.ws + WS_R + R_PROJ) + (size_t)row * 2048;
    unsigned* ctl = (unsigned*)(a.ws + WS_CTL);
    CmE1 cm;
    for (int n = tid; n < 1968; n += 512) probe_err(ctl, bf1(proj[cm(n)]) - ref[n]);
    for (int n = 432 + tid; n < 512; n += 512) probe_err(ctl, bf1(proj[n]));
}

__global__ void probe_e2(Args a, int layer) {
    __shared__ float cq[256]; __shared__ float ckv[128]; __shared__ float red[8]; __shared__ float ref[1024];
    const int row = (blockIdx.x * 131 + 7) % S, tid = threadIdx.x, j = layer >> 1;
    const bf16_t* proj = (const bf16_t*)(a.ws + WS_R + R_PROJ) + (size_t)row * 2048;
    unsigned* ctl = (unsigned*)(a.ws + WS_CTL);
    float s2 = 0.f; if (tid < 256) { cq[tid] = bf1(proj[tid]); s2 = cq[tid] * cq[tid]; }
    s2 = wave_sum(s2); if ((tid & 63) == 0) red[tid >> 6] = s2; __syncthreads();
    float tot = 0.f; for (int i = 0; i < 8; ++i) tot += red[i];
    const float rq = rsqrtf(tot / 256.f + EPS);
    __syncthreads();
    s2 = 0.f; if (tid < 128) { ckv[tid] = bf1(proj[256 + tid]); s2 = ckv[tid] * ckv[tid]; }
    s2 = wave_sum(s2); if ((tid & 63) == 0) red[tid >> 6] = s2; __syncthreads();
    tot = 0.f; for (int i = 0; i < 8; ++i) tot += red[i];
    const float rkv = rsqrtf(tot / 128.f + EPS);
    if (tid < 256) cq[tid] *= rq * a.in[11][j * 256 + tid];
    if (tid < 128) ckv[tid] *= rkv * a.in[13][j * 128 + tid];
    __syncthreads();
    const float* Wq = a.in[12] + (size_t)j * 256 * 768; const float* Wkv = a.in[14] + (size_t)j * 128 * 1024;
    const float qs = 0.10206207261596575f * LOG2E;
    for (int n = tid; n < 768; n += 512) { float acc = 0.f; for (int k = 0; k < 256; ++k) acc += cq[k] * Wq[(size_t)k * 768 + n]; ref[n] = acc * qs; }
    __syncthreads();
    const int pos = ((const int*)a.in[2])[row];
    if (tid < 128) { const int hh = tid >> 4, i = tid & 15; const float inv = powf(10000.f, -(float)i / 16.f); const float ang = (float)pos * inv; const float cs = cosf(ang), sn = sinf(ang);
        const float x1 = ref[hh * 96 + 64 + i], x2 = ref[hh * 96 + 80 + i]; ref[hh * 96 + 64 + i] = x1 * cs - x2 * sn; ref[hh * 96 + 80 + i] = x2 * cs + x1 * sn; }
    __syncthreads();
    const bf16_t* Q = (const bf16_t*)(a.ws + WS_R + R_Q) + (size_t)row * 768;
    CmQ cmq; for (int n = tid; n < 768; n += 512) probe_err(ctl, (bf1(Q[cmq(n)]) - ref[n]) * (1.f / 0.147f));
    __syncthreads();
    for (int n = tid; n < 1024; n += 512) { float acc = 0.f; for (int k = 0; k < 128; ++k) acc += ckv[k] * Wkv[(size_t)k * 1024 + n]; ref[n] = acc; }
    __syncthreads();
    const bf16_t* KN = (const bf16_t*)(a.ws + WS_R + R_KN) + (size_t)row * 512; const bf16_t* V = (const bf16_t*)(a.ws + WS_R + R_V) + (size_t)row * 512;
    for (int n = tid; n < 1024; n += 512) { const int hh = n >> 7, r = n & 127; const float got = r < 64 ? bf1(KN[hh * 64 + r]) : bf1(V[hh * 64 + r - 64]); probe_err(ctl, got - ref[n]); }
}
__global__ void __launch_bounds__(256) probe_mla(Args a) {
    __shared__ float q[96]; __shared__ float red[4]; __shared__ float ored[4][64]; __shared__ float lred[4];
    const int si = blockIdx.x >> 3, head = blockIdx.x & 7, tid = threadIdx.x;
    int row = (si * 529 + (si % 3) * 63) % S;
    switch (si) { case 0: row = 0; break; case 1: row = 1; break; case 2: row = 63; break; case 3: row = 64; break; case 4: row = 255; break; case 5: row = 256; break;
                  case 6: row = 257; break; case 7: row = 4095; break; case 8: row = 4096; break; case 9: row = 8191; break; case 10: row = 16383; break; case 11: row = 16128; break; default: break; }
    const bf16_t* Q = (const bf16_t*)(a.ws + WS_R + R_Q); const bf16_t* KN = (const bf16_t*)(a.ws + WS_R + R_KN); const bf16_t* V = (const bf16_t*)(a.ws + WS_R + R_V);
    const bf16_t* PJ = (const bf16_t*)(a.ws + WS_R + R_PROJ); const bf16_t* CAT = (const bf16_t*)(a.ws + WS_R + R_CAT);
    unsigned* ctl = (unsigned*)(a.ws + WS_CTL);
    if (tid < 96) q[tid] = bf1(Q[(size_t)row * 768 + head * 96 + tid]);
    __syncthreads();
    float mx = -INFINITY;
    for (int k = tid; k <= row; k += 256) { float sc = 0.f; for (int d = 0; d < 64; ++d) sc += q[d] * bf1(KN[(size_t)k * 512 + head * 64 + d]);
        for (int d = 0; d < 32; ++d) sc += q[64 + d] * bf1(PJ[(size_t)k * 2048 + PJ_KPE + d]); mx = fmaxf(mx, sc); }
    for (int o = 1; o < 64; o <<= 1) mx = fmaxf(mx, __shfl_xor(mx, o));
    if ((tid & 63) == 0) red[tid >> 6] = mx; __syncthreads();
    mx = fmaxf(fmaxf(red[0], red[1]), fmaxf(red[2], red[3]));
    float l = 0.f; float o[64];
#pragma unroll
    for (int d = 0; d < 64; ++d) o[d] = 0.f;
    for (int k = tid; k <= row; k += 256) { float sc = 0.f; for (int d = 0; d < 64; ++d) sc += q[d] * bf1(KN[(size_t)k * 512 + head * 64 + d]);
        for (int d = 0; d < 32; ++d) sc += q[64 + d] * bf1(PJ[(size_t)k * 2048 + PJ_KPE + d]);
        const float p = exp2f(sc - mx); l += p;
#pragma unroll
        for (int d = 0; d < 64; ++d) o[d] += p * bf1(V[(size_t)k * 512 + head * 64 + d]); }
    l = wave_sum(l);
#pragma unroll
    for (int d = 0; d < 64; ++d) o[d] = wave_sum(o[d]);
    if ((tid & 63) == 0) { lred[tid >> 6] = l;
#pragma unroll
        for (int d = 0; d < 64; ++d) ored[tid >> 6][d] = o[d]; }
    __syncthreads();
    if (tid < 64) { const float lt = lred[0] + lred[1] + lred[2] + lred[3]; const float ov = (ored[0][tid] + ored[1][tid] + ored[2][tid] + ored[3][tid]) / lt;
        probe_err(ctl, bf1(CAT[(size_t)row * 1024 + head * 64 + tid]) - ov); }
}
__global__ void __launch_bounds__(128) probe_gla(Args a, int layer) {
    __shared__ float qa[64], ka[64], aa[64], red[2];
    const int head = blockIdx.x, dv = threadIdx.x, j = layer >> 1;
    const bf16_t* PJ = (const bf16_t*)(a.ws + WS_R + R_PROJ); const bf16_t* CAT = (const bf16_t*)(a.ws + WS_R + R_CAT);
    const float* wg = a.in[15] + (size_t)j * 16 * 256; const float* bg = a.in[16] + j * 256; const float* gn = a.in[17] + j * 128;
    unsigned* ctl = (unsigned*)(a.ws + WS_CTL);
    float st[64];
#pragma unroll
    for (int d = 0; d < 64; ++d) st[d] = 0.f;
    for (int t = 0; t < S; ++t) {
        const bf16_t* pr = PJ + (size_t)t * 2048;
        if (dv < 64) { float x = bg[head * 64 + dv]; for (int jj = 0; jj < 16; ++jj) x += bf1(pr[PJ_GLR + jj]) * wg[jj * 256 + head * 64 + dv];
            aa[dv] = expf(logsigmoid_ref(x) / 16.f); qa[dv] = bf1(pr[PJ_GQ + head * 64 + dv]) * 0.125f; ka[dv] = bf1(pr[PJ_GK + head * 64 + dv]); }
        __syncthreads();
        const float v = bf1(pr[PJ_GV + head * 128 + dv]);
        float o = 0.f;
#pragma unroll
        for (int d = 0; d < 64; ++d) { st[d] = aa[d] * st[d] + ka[d] * v; o += qa[d] * st[d]; }
        const bool sample = (t % 61 == 0) || t >= S - 64 || t < 130;
        if (sample) {
            float s2 = wave_sum(o * o); if ((dv & 63) == 0) red[dv >> 6] = s2; __syncthreads();
            const float rs = rsqrtf((red[0] + red[1]) / 128.f + EPS);
            const float ref = o * rs * gn[dv] * silu_f(bf1(pr[PJ_R + head * 128 + dv]));
            probe_rms(ctl, bf1(CAT[(size_t)t * 1024 + 512 + head * 128 + dv]), ref);
        }
        __syncthreads();
    }
}
__global__ void __launch_bounds__(256) probe_o23(Args a, int layer) {
    __shared__ float xm[1024], xc[1024], qkv[3072], red[4];
    const int tid = threadIdx.x, j = layer >> 1;
    int t = (blockIdx.x * 257 + 3) % S; if (blockIdx.x < 4) t = blockIdx.x; if (blockIdx.x == 4) t = 255; if (blockIdx.x == 5) t = 256; if (blockIdx.x == 6) t = S - 1;
    const bf16_t* XM = (const bf16_t*)(a.ws + WS_R + R_XM); const bf16_t* XC = (const bf16_t*)(a.ws + WS_R + R_XC);
    const bf16_t* MQ = (const bf16_t*)(a.ws + WS_R + R_MQ); const bf16_t* MK = (const bf16_t*)(a.ws + WS_R + R_MK); const bf16_t* MV = (const bf16_t*)(a.ws + WS_R + R_MV);
    const float* gates = (const float*)(a.ws + WS_GATES);
    unsigned* ctl = (unsigned*)(a.ws + WS_CTL);
    const float* cw = a.in[20] + (size_t)j * 4 * 1024; const float* cb = a.in[21] + j * 1024;
    for (int ch = tid; ch < 1024; ch += 256) {
        float y = cb[ch];
        for (int i = 0; i < 4; ++i) { const int tt = t - 3 + i; if (tt >= 0) y += cw[i * 1024 + ch] * bf1(XM[(size_t)tt * 1024 + ch]); }
        const float v = y / (1.f + expf(-y));
        xm[ch] = bf1(XM[(size_t)t * 1024 + ch]); xc[ch] = v;
        probe_rms(ctl, bf1(XC[(size_t)t * 1024 + ch]), v);
    }
    __syncthreads();
    for (int o = tid; o < 3072; o += 256) {
        const int which = o >> 10, hh = (o >> 8) & 3, e = o & 255;
        const float* W = a.in[22 + which] + ((size_t)j * 4 + hh) * 65536;
        const float* src = (which == 2 ? xm : xc) + hh * 256;
        float acc = 0.f; for (int d = 0; d < 256; ++d) acc += src[d] * W[d * 256 + e];
        qkv[hh * 768 + which * 256 + e] = acc;
        const bf16_t* M = which == 0 ? MQ : which == 1 ? MK : MV;
        probe_rms(ctl, bf1(M[(size_t)t * 1024 + hh * 256 + e]), which == 0 ? acc * 0.0625f : acc);
    }
    __syncthreads();
    for (int g = 0; g < 8; ++g) {
        float acc = 0.f; for (int i = tid; i < 3072; i += 256) acc += qkv[i] * a.in[25][(size_t)j * 3072 * 8 + (size_t)i * 8 + g];
        acc = wave_sum(acc); if ((tid & 63) == 0) red[tid >> 6] = acc; __syncthreads();
        if (tid == 0) { const float ref = red[0] + red[1] + red[2] + red[3] + a.in[26][j * 8 + g]; probe_rms(ctl, gates[(size_t)t * 8 + g] * 4.f, ref * 4.f); probe_err(ctl, (gates[(size_t)t * 8 + g] - ref) * 0.2f); }
        __syncthreads();
    }
}
__global__ void __launch_bounds__(512) probe_mlstm(Args a, int layer) {
    __shared__ float q[256], k[256], numred[2][256], red[16], red2[4];
    const int head = blockIdx.x, tid = threadIdx.x, dv = tid & 255, part = tid >> 8, j = layer >> 1;
    const bf16_t* MQ = (const bf16_t*)(a.ws + WS_R + R_MQ); const bf16_t* MK = (const bf16_t*)(a.ws + WS_R + R_MK); const bf16_t* MV = (const bf16_t*)(a.ws + WS_R + R_MV);
    const bf16_t* XC = (const bf16_t*)(a.ws + WS_R + R_XC); const bf16_t* Z = (const bf16_t*)(a.ws + WS_R + R_Z); const bf16_t* OUTM = (const bf16_t*)(a.ws + WS_HB);
    const float* gates = (const float*)(a.ws + WS_GATES); unsigned* ctl = (unsigned*)(a.ws + WS_CTL);
    float C[128];
#pragma unroll
    for (int i = 0; i < 128; ++i) C[i] = 0.f;
    float nn = 0.f, m = 0.f;
    for (int t = 0; t < S; ++t) {
        if (tid < 256) { q[tid] = bf1(MQ[(size_t)t * 1024 + head * 256 + tid]); k[tid] = bf1(MK[(size_t)t * 1024 + head * 256 + tid]); }
        __syncthreads();
        const float v = bf1(MV[(size_t)t * 1024 + head * 256 + dv]);
        const float ii = gates[(size_t)t * 8 + head], lf = logsigmoid_ref(gates[(size_t)t * 8 + 4 + head]);
        const float mnew = fmaxf(lf + m, ii), fd = expf(lf + m - mnew), idd = expf(ii - mnew); m = mnew;
        float num = 0.f;
#pragma unroll
        for (int i = 0; i < 128; ++i) { const int dk = part * 128 + i; C[i] = fd * C[i] + idd * k[dk] * v; num += q[dk] * C[i]; }
        numred[part][dv] = num;
        float dp = 0.f;
        if (tid < 256) { nn = fd * nn + idd * k[tid]; dp = q[tid] * nn; }
        dp = wave_sum(dp); if ((tid & 63) == 0) red[tid >> 6] = dp;
        __syncthreads();
        const bool sample = (t % 53 == 0) || t < 300 || t >= S - 300;
        if (sample) {
            const float den = red[0] + red[1] + red[2] + red[3] + red[4] + red[5] + red[6] + red[7];
            float hv = 0.f, s1 = 0.f, s2 = 0.f;
            if (tid < 256) { hv = (numred[0][dv] + numred[1][dv]) / fmaxf(fabsf(den), expf(-m)); s1 = hv; }
            s1 = wave_sum(s1); if ((tid & 63) == 0 && tid < 256) red2[tid >> 6] = s1; __syncthreads();
            const float mu = (red2[0] + red2[1] + red2[2] + red2[3]) / 256.f; __syncthreads();
            if (tid < 256) s2 = (hv - mu) * (hv - mu);
            s2 = wave_sum(s2); if ((tid & 63) == 0 && tid < 256) red2[tid >> 6] = s2; __syncthreads();
            const float rstd = rsqrtf((red2[0] + red2[1] + red2[2] + red2[3]) / 256.f + EPS);
            if (tid < 256) { const size_t gi = (size_t)t * 1024 + head * 256 + dv;
                const float ref = ((hv - mu) * rstd * a.in[27][j * 1024 + head * 256 + dv] + a.in[28][j * 1024 + head * 256 + dv] * bf1(XC[gi])) * silu_f(bf1(Z[gi]));
                probe_rms(ctl, bf1(OUTM[gi]), ref); }
        }
        __syncthreads();
    }
}
#endif

__global__ void __launch_bounds__(NTHREADS, 2) fwd(Args args) {
    extern __shared__ __attribute__((aligned(16))) unsigned char lds_raw[];
    typedef const Args __attribute__((address_space(4)))* ArgsP;
    ArgsP ap0 = (ArgsP)__builtin_amdgcn_kernarg_segment_ptr();
#define ARGS() ({ ArgsP _q = ap0; asm volatile("" : "+s"(_q)); _q; })
    const int lo = ap0->ph_lo, hi = ap0->ph_hi;
    const int wave0 = __builtin_amdgcn_readfirstlane((int)threadIdx.x >> 6);
    const bool multi = (hi - lo) > 1;
    XcdBarrier bar; bar.bar = (unsigned*)(ap0->ws + WS_CTL) + 4096; bar.x = 0; bar.st = (volatile LAS unsigned*)((LAS unsigned char*)lds_raw + LDS_MISC);
    if (multi) {
        if (threadIdx.x == 0) { bar.st[0] = 0u; bar.st[1] = 0u; bar.st[2] = 0u; bar.st[3] = 0u; }
        __syncthreads();
        bar = xcd_barrier_post(bar.bar, bar.st, (int)threadIdx.x);
    }
#define END_PHASE(k) do { if (multi && ((k) + 1 < hi || REP_N > 1)) xcd_barrier(bar, c.tid); } while (0)
#define IN(k) (lo <= (k) && (k) < hi)
#define PHASE_CTX() \
    Ctx c; { int w_ = wave0; asm volatile("" : "+s"(w_)); unsigned z_ = 0u; asm volatile("" : "+s"(z_)); int l_ = (int)__builtin_amdgcn_mbcnt_hi(~0u, __builtin_amdgcn_mbcnt_lo(~0u, z_)); \
      c.lds = (LAS unsigned char*)lds_raw; c.tid = w_ * 64 + l_; c.lane = l_; c.wave = w_; \
      c.G = gridDim.x; const int bx_ = blockIdx.x; c.vcu = (c.G % 8 == 0) ? (bx_ % 8) * (c.G / 8) + bx_ / 8 : bx_; c.gw = c.vcu * NWAVES + c.wave; c.NGW = c.G * NWAVES; } \
    ArgsP ap = ARGS(); unsigned char* ws = ap->ws; float* h = ap->out; \
    float* cosT = (float*)(ws + WS_COS); float* sinT = (float*)(ws + WS_SIN); \
    float* rsx = (float*)(ws + WS_RSX); float* ssq16 = (float*)(ws + WS_SSQ16); \
    float* ssqq = (float*)(ws + WS_SSQQ); float* ssqkv = (float*)(ws + WS_SSQKV); \
    bf16_t* HB = (bf16_t*)(ws + WS_HB); bf16_t* MIX = (bf16_t*)(ws + WS_MIX); \
    unsigned char* R = ws + WS_R; unsigned char* WB = ws + WS_WB; \
    (void)h; (void)cosT; (void)sinT; (void)rsx; (void)ssq16; (void)ssqq; (void)ssqkv; (void)HB; (void)MIX; (void)R; (void)WB;

    if (IN(0)) {
        PHASE_CTX();
        const float* x = ap->in[0]; const int* pos = (const int*)ap->in[2];
        for (int i = c.gw * 64 + c.lane; i < S * 16; i += c.NGW * 64) {
            const int t = i >> 4, f = i & 15;
            const double inv = pow(10000.0, -(double)f / 16.0);
            const double ang = (double)pos[t] * inv;
            cosT[i] = (float)cos(ang); sinT[i] = (float)sin(ang);
        }
        for (int row = c.gw; row < S; row += c.NGW) {
            const float* xr = x + (size_t)row * D; bf16_t* br = HB + (size_t)row * D;
            float s2 = 0.f;
#pragma unroll
            for (int j = 0; j < 4; ++j) {
                const f32x4 v = *(const f32x4*)(xr + 4 * c.lane + 256 * j);
                s2 += sq4(v);
                u32x2 o; o.x = pk2(v[0], v[1]); o.y = pk2(v[2], v[3]);
                *(u32x2*)(br + 4 * c.lane + 256 * j) = o;
            }
            s2 = wave_sum(s2);
            if (c.lane == 0) rsx[row] = rsqrtf(s2 * (1.f / 1024.f) + EPS);
        }
        for (int rr = c.gw; rr < NLAYER * NMEM; rr += c.NGW) {
            const int l = rr >> 8, row = rr & 255;
            const float* mr = ap->in[1] + (size_t)row * D; const float* g = ap->in[7] + l * 1024; bf16_t* br = (bf16_t*)(ws + WS_MEMN) + (size_t)rr * D;
            f32x4 v[4]; float s2 = 0.f;
#pragma unroll
            for (int j = 0; j < 4; ++j) { v[j] = *(const f32x4*)(mr + 4 * c.lane + 256 * j); s2 += sq4(v[j]); }
            s2 = wave_sum(s2);
            const float rs = rsqrtf(s2 * (1.f / 1024.f) + EPS);
#pragma unroll
            for (int j = 0; j < 4; ++j) { const f32x4 gg = *(const f32x4*)(g + 4 * c.lane + 256 * j); const f32x4 o4 = v[j] * gg * rs;
                u32x2 o; o.x = pk2(o4[0], o4[1]); o.y = pk2(o4[2], o4[3]); *(u32x2*)(br + 4 * c.lane + 256 * j) = o; }
        }
        for (int l = 0; l < NLAYER; ++l) {
            prep_job(c, ap->in[31] + (size_t)l * 1024 * 1024, 1024, 1024, 1024, nullptr, 1.f, (bf16_t*)(R + R_XKT) + (size_t)(l * 2 + 0) * 1024 * 1024, 1024, CmId{0});
            prep_job(c, ap->in[32] + (size_t)l * 1024 * 1024, 1024, 1024, 1024, nullptr, 1.f, (bf16_t*)(R + R_XKT) + (size_t)(l * 2 + 1) * 1024 * 1024, 1024, CmId{0});
        }
     END_PHASE(0); }
    if (IN(1)) {
        PHASE_CTX();
        pg8::StaticOrder so; so.init(1, 32, c.G, (int)blockIdx.x);
        ProbKV P{(const bf16_t*)(ws + WS_MEMN), (const bf16_t*)(R + R_XKT), 1024, 1024, 16, (bf16_t*)(ws + WS_KX), (bf16_t*)(ws + WS_VX)};
        pg8::gemm_phase(c.lds, c.tid, so, P);
     END_PHASE(1); }
    for (int l = 0; l < NLAYER; ++l) {
        const int pb = 2 + l * 16;
        const bool even = (l & 1) == 0;
        for (int rep_ = 0; rep_ < REPS(0); ++rep_) if (IN(pb + 0)) {
            PHASE_CTX(); int L = l; asm volatile("" : "+s"(L)); const int J = L >> 1; (void)J;
            prep_layer(c, ap, ws, L);
 END_PHASE(pb + 0); }
        if (even) {
            for (int rep_ = 0; rep_ < REPS(1); ++rep_) if (IN(pb + 1)) {
                PHASE_CTX(); int L = l; asm volatile("" : "+s"(L)); const int J = L >> 1; (void)J;
                pg8::StaticOrder so; so.init(S / 256, 8, c.G, (int)blockIdx.x);
                ProbE1 P{HB, (const bf16_t*)(WB + WB_WIN), 1024, 1024, 16, (bf16_t*)(R + R_PROJ), rsx, ssqq, ssqkv, cosT, sinT};
                pg8::gemm_phase(c.lds, c.tid, so, P);
             END_PHASE(pb + 1); }
            for (int rep_ = 0; rep_ < REPS(2); ++rep_) if (IN(pb + 2)) {
                PHASE_CTX(); int L = l; asm volatile("" : "+s"(L)); const int J = L >> 1; (void)J;
                pg8::StaticOrder so; so.init(S / 256, 7, c.G, (int)blockIdx.x);
                ProbE2 P{(const bf16_t*)(R + R_PROJ), (const bf16_t*)(WB + WB_WUQ), (const bf16_t*)(WB + WB_WUKV), 2048, 256, 4,
                         (bf16_t*)(R + R_Q), (bf16_t*)(R + R_KN), (bf16_t*)(R + R_V), ssqq, ssqkv, cosT, sinT};
                pg8::gemm_phase(c.lds, c.tid, so, P);
                for (int u = c.vcu; u < 1024; u += c.G)
                    gla_a_unit(c, (const bf16_t*)(R + R_PROJ), ap->in[15] + (size_t)J * 16 * 256, ap->in[16] + J * 256, u >> 2, u & 3, (bf16_t*)(R + R_GST), (float*)(ws + WS_GDEC));
             END_PHASE(pb + 2); }
            for (int rep_ = 0; rep_ < REPS(3); ++rep_) if (IN(pb + 3)) {
                PHASE_CTX(); int L = l; asm volatile("" : "+s"(L)); const int J = L >> 1; (void)J;
                const bf16_t* Q = (const bf16_t*)(R + R_Q); const bf16_t* KN = (const bf16_t*)(R + R_KN); const bf16_t* V = (const bf16_t*)(R + R_V);
                const bf16_t* PJ = (const bf16_t*)(R + R_PROJ); bf16_t* CAT = (bf16_t*)(R + R_CAT);
                if (rep_ == 0) gla_scan(c, (bf16_t*)(R + R_GST), (const float*)(ws + WS_GDEC));
                for (int u = c.vcu; u < 256; u += c.G) {
                    const int head = u >> 5, sidx = u & 31;
                    for (int half = 0; half < 2; ++half) {
                        const int qb = half ? 63 - sidx : sidx;
                        const size_t r0 = (size_t)qb * 256 + c.wave * 32;
                        flash_unit<8, 4, 2, 2, true>(c, Q + r0 * 768 + head * 96, 768, KN + head * 64, 512, PJ + PJ_KPE, 2048, V + head * 64, 512,
                                                     CAT + r0 * 1024 + head * 64, 1024, 4 * (qb + 1), 0, c.wave * 32, 4 * qb);
                    }
                }
             END_PHASE(pb + 3); }
            for (int rep_ = 0; rep_ < REPS(4); ++rep_) if (IN(pb + 4)) {
                PHASE_CTX(); int L = l; asm volatile("" : "+s"(L)); const int J = L >> 1; (void)J;
                for (int u = c.vcu; u < 1024; u += c.G)
                    gla_c_unit(c, (const bf16_t*)(R + R_PROJ), ap->in[15] + (size_t)J * 16 * 256, ap->in[16] + J * 256, ap->in[17] + J * 128, u >> 2, u & 3, (const bf16_t*)(R + R_GST), (bf16_t*)(R + R_CAT));
             END_PHASE(pb + 4); }
            for (int rep_ = 0; rep_ < REPS(5); ++rep_) if (IN(pb + 5)) {
                PHASE_CTX(); int L = l; asm volatile("" : "+s"(L)); const int J = L >> 1; (void)J;
                pg8::StaticOrder so; so.init(S / 256, 4, c.G, (int)blockIdx.x);
                ProbPlain P{(const bf16_t*)(R + R_CAT), (const bf16_t*)(WB + WB_WOUT), 1024, 1024, 16, MIX, 1024, nullptr, 1 << 30, nullptr, 0, ssq16, 16};
                pg8::gemm_phase(c.lds, c.tid, so, P);
             END_PHASE(pb + 5); }
        }
        if (!even) {
            for (int rep_ = 0; rep_ < REPS(101); ++rep_) if (IN(pb + 1)) {
                PHASE_CTX(); int L = l; asm volatile("" : "+s"(L)); const int J = L >> 1; (void)J;
                pg8::StaticOrder so; so.init(S / 256, 8, c.G, (int)blockIdx.x);
                ProbPlain P{HB, (const bf16_t*)(WB + WB_WIN), 1024, 1024, 16, (bf16_t*)(R + R_XM), 1024, (bf16_t*)(R + R_Z), 4, rsx, 0, nullptr, 0};
                pg8::gemm_phase(c.lds, c.tid, so, P);
             END_PHASE(pb + 1); }
            for (int rep_ = 0; rep_ < REPS(102); ++rep_) if (IN(pb + 2)) {
                PHASE_CTX(); int L = l; asm volatile("" : "+s"(L)); const int J = L >> 1; (void)J;
                conv_phase(c, (const bf16_t*)(R + R_XM), ap->in[20] + (size_t)J * 4 * 1024, ap->in[21] + J * 1024, (const float*)(ws + WS_G12), ap->in[26] + J * 8,
                           (bf16_t*)(R + R_XC), (float*)(ws + WS_GATES));
             END_PHASE(pb + 2); }
            for (int rep_ = 0; rep_ < REPS(103); ++rep_) if (IN(pb + 3)) {
                PHASE_CTX(); int L = l; asm volatile("" : "+s"(L)); const int J = L >> 1; (void)J;
                pg8::StaticOrder so; so.init(S / 256, 12, c.G, (int)blockIdx.x);
                ProbO3 P{(const bf16_t*)(R + R_XC), (const bf16_t*)(R + R_XM), (const bf16_t*)(WB + WB_W3), 1024, 256, 4, (bf16_t*)(R + R_MQ), (bf16_t*)(R + R_MK), (bf16_t*)(R + R_MV)};
                pg8::gemm_phase(c.lds, c.tid, so, P);
             END_PHASE(pb + 3); }
            for (int rep_ = 0; rep_ < REPS(104); ++rep_) if (IN(pb + 4)) {
                PHASE_CTX(); int L = l; asm volatile("" : "+s"(L)); const int J = L >> 1; (void)J;
                for (int u = c.vcu; u < 63 * 4; u += c.G)
                    mlstm_a_unit(c, (const float*)(ws + WS_GATES), (const bf16_t*)(R + R_MK), (const bf16_t*)(R + R_MV), u >> 2, u & 3, (bf16_t*)(R + R_XM), (float*)(ws + WS_MST));
             END_PHASE(pb + 4); }
            for (int rep_ = 0; rep_ < REPS(105); ++rep_) if (IN(pb + 5)) { PHASE_CTX(); int L = l; asm volatile("" : "+s"(L)); const int J = L >> 1; (void)J; mlstm_scan(c, (bf16_t*)(R + R_XM), (float*)(ws + WS_MST));  END_PHASE(pb + 5); }
            for (int rep_ = 0; rep_ < REPS(106); ++rep_) if (IN(pb + 6)) {
                PHASE_CTX(); int L = l; asm volatile("" : "+s"(L)); const int J = L >> 1; (void)J;
                for (int u = c.vcu; u < 512; u += c.G)
                    mlstm_c_unit(c, (const float*)(ws + WS_GATES), (const bf16_t*)(R + R_MQ), (const bf16_t*)(R + R_MK), (const bf16_t*)(R + R_MV), (const bf16_t*)(R + R_XM), (const float*)(ws + WS_MST),
                                 (const bf16_t*)(R + R_XC), (const bf16_t*)(R + R_Z), ap->in[27] + J * 1024, ap->in[28] + J * 1024, (bf16_t*)h  , u >> 3, (u >> 1) & 3, u & 1);
             END_PHASE(pb + 6); }
            for (int rep_ = 0; rep_ < REPS(107); ++rep_) if (IN(pb + 7)) {
                PHASE_CTX(); int L = l; asm volatile("" : "+s"(L)); const int J = L >> 1; (void)J;
                pg8::StaticOrder so; so.init(S / 256, 4, c.G, (int)blockIdx.x);
                ProbPlain P{(const bf16_t*)h, (const bf16_t*)(WB + WB_WOUT), 1024, 1024, 16, MIX, 1024, nullptr, 1 << 30, nullptr, 0, ssq16, 16};
                pg8::gemm_phase(c.lds, c.tid, so, P);
             END_PHASE(pb + 7); }
        }
        for (int rep_ = 0; rep_ < REPS(8); ++rep_) if (IN(pb + 8)) { PHASE_CTX(); int L = l; asm volatile("" : "+s"(L)); const int J = L >> 1; (void)J; norm_phase(c, MIX, ssq16, ap->in[4] + L * 1024, nullptr, HB, rsx);  END_PHASE(pb + 8); }
        for (int rep_ = 0; rep_ < REPS(9); ++rep_) if (IN(pb + 9)) {
            PHASE_CTX(); int L = l; asm volatile("" : "+s"(L)); const int J = L >> 1; (void)J;
            pg8::StaticOrder so; so.init(S / 256, 4, c.G, (int)blockIdx.x);
            ProbPlain P{HB, (const bf16_t*)(WB + WB_XQ), 1024, 1024, 16, (bf16_t*)(R + R_XQ), 1024, nullptr, 1 << 30, rsx, 0, nullptr, 0};
            pg8::gemm_phase(c.lds, c.tid, so, P);
         END_PHASE(pb + 9); }
        for (int rep_ = 0; rep_ < REPS(10); ++rep_) if (IN(pb + 10)) {
            PHASE_CTX(); int L = l; asm volatile("" : "+s"(L)); const int J = L >> 1; (void)J;
            const bf16_t* XQ = (const bf16_t*)(R + R_XQ); bf16_t* XO = (bf16_t*)(R + R_XO);
            const bf16_t* KX = (const bf16_t*)(ws + WS_KX) + (size_t)L * 256 * 1024; const bf16_t* VX = (const bf16_t*)(ws + WS_VX) + (size_t)L * 256 * 1024;
            const int rg = c.wave >> 1, dvh = c.wave & 1;
            for (int u = c.vcu; u < 512; u += c.G) {
                const int pp = u >> 2, head = u & 3;
                const size_t r0 = (size_t)pp * 128 + rg * 32;
                flash_unit<32, 0, 8, 4, false>(c, XQ + r0 * 1024 + head * 256, 1024, KX + head * 256, 1024, KX, 1024, VX + head * 256, 1024,
                                               XO + r0 * 1024 + head * 256 + dvh * 128, 1024, 4, dvh * 4, 0, 0);
            }
         END_PHASE(pb + 10); }
        for (int rep_ = 0; rep_ < REPS(11); ++rep_) if (IN(pb + 11)) {
            PHASE_CTX(); int L = l; asm volatile("" : "+s"(L)); const int J = L >> 1; (void)J;
            pg8::StaticOrder so; so.init(S / 256, 4, c.G, (int)blockIdx.x);
            ProbPlain P{(const bf16_t*)(R + R_XO), (const bf16_t*)(WB + WB_XO), 1024, 1024, 16, MIX, 1024, nullptr, 1 << 30, nullptr, 0, ssq16, 16};
            pg8::gemm_phase(c.lds, c.tid, so, P);
         END_PHASE(pb + 11); }
        for (int rep_ = 0; rep_ < REPS(12); ++rep_) if (IN(pb + 12)) { PHASE_CTX(); int L = l; asm volatile("" : "+s"(L)); const int J = L >> 1; (void)J; norm_phase(c, MIX, ssq16, ap->in[6] + L * 1024, nullptr, HB, rsx);  END_PHASE(pb + 12); }
        for (int rep_ = 0; rep_ < REPS(13); ++rep_) if (IN(pb + 13)) {
            PHASE_CTX(); int L = l; asm volatile("" : "+s"(L)); const int J = L >> 1; (void)J;
            pg8::StaticOrder so; so.init(S / 256, 16, c.G, (int)blockIdx.x);
            ProbPlain P{HB, (const bf16_t*)(WB + WB_W1), 1024, 1024, 16, (bf16_t*)(R + R_U), 4096, nullptr, 1 << 30, rsx, 1, nullptr, 0};
            pg8::gemm_phase(c.lds, c.tid, so, P);
         END_PHASE(pb + 13); }
        for (int rep_ = 0; rep_ < REPS(14); ++rep_) if (IN(pb + 14)) {
            PHASE_CTX(); int L = l; asm volatile("" : "+s"(L)); const int J = L >> 1; (void)J;
            pg8::StaticOrder so; so.init(S / 256, 4, c.G, (int)blockIdx.x);
            ProbPlain P{(const bf16_t*)(R + R_U), (const bf16_t*)(WB + WB_W2), 4096, 4096, 64, MIX, 1024, nullptr, 1 << 30, nullptr, 0, ssq16, 16};
            pg8::gemm_phase(c.lds, c.tid, so, P);
         END_PHASE(pb + 14); }
        for (int rep_ = 0; rep_ < REPS(15); ++rep_) if (IN(pb + 15)) { PHASE_CTX(); int L = l; asm volatile("" : "+s"(L)); const int J = L >> 1; (void)J; norm_phase(c, MIX, ssq16, ap->in[9] + L * 1024, L == NLAYER - 1 ? h : nullptr, HB, rsx);  END_PHASE(pb + 15); }
    }
#undef IN
}

extern "C" void kernel_launch(void* const* d_in, const int* in_sizes, int n_in, void* d_out, int out_size, void* d_ws, size_t ws_size, hipStream_t stream) {
    static int grid = 0;
    if (grid == 0) {
        if (n_in != 36 || out_size != S * D || ws_size < WS_END) { fprintf(stderr, "kernel_launch: unexpected shapes (n_in %d, out %d, ws %zu < %zu)\n", n_in, out_size, ws_size, (size_t)WS_END); grid = -1; return; }
        int dev = 0, cus = 0, per_cu = 0;
        hipGetDevice(&dev); hipDeviceGetAttribute(&cus, hipDeviceAttributeMultiprocessorCount, dev);
        if (hipFuncSetAttribute((const void*)fwd, hipFuncAttributeMaxDynamicSharedMemorySize, LDS_BYTES) != hipSuccess) { fprintf(stderr, "kernel_launch: hipFuncSetAttribute failed\n"); grid = -1; return; }
        hipOccupancyMaxActiveBlocksPerMultiprocessor(&per_cu, (const void*)fwd, NTHREADS, LDS_BYTES);
        (void)hipGetLastError();
        grid = cus > 0 ? cus : 256;
    }
    if (grid < 0) return;
    hipMemsetAsync((char*)d_ws + WS_CTL, 0, 1 * MiB, stream);
    Args a{};
    for (int i = 0; i < 36; ++i) a.in[i] = (const float*)d_in[i];
    a.out = (float*)d_out; a.ws = (unsigned char*)d_ws;
    const int PH_END = 2 + 16 * NLAYER;
#if MULTI_LAUNCH
    for (int p = 0; p < PH_END; ++p) {
        a.ph_lo = p; a.ph_hi = p + 1;
        hipLaunchKernelGGL(fwd, dim3(grid), dim3(NTHREADS), LDS_BYTES, stream, a);
    }
#else
    a.ph_lo = 0; a.ph_hi = PH_END;
    hipLaunchKernelGGL(fwd, dim3(grid), dim3(NTHREADS), LDS_BYTES, stream, a);
#endif
#if PROBE
    hipLaunchKernelGGL(probe_mlstm, dim3(4), dim3(512), 0, stream, a, 1);
    hipLaunchKernelGGL(probe_report, dim3(1024), dim3(256), 0, stream, (const unsigned*)d_ws, (const float*)d_in[0], (float*)d_out);
#endif
}
```
